# Optimizing an MI355X kernel written in HIP

```python
import math
import jax, jax.numpy as jnp
from jax import lax
import numpy as np


D_MODEL = 2048
BATCH = 2
SEQ = 8192
DEPTH = 4
DEC_BATCH = 2
DEC_SEQ = 4096
PAST_LEN = 128

GRID_W = 64
BRANCH_WIDTH = 512
N_BRANCH = 4
POOL_WINDOWS = (2, 4, 8, 16)
POOL_GROUP = BRANCH_WIDTH // len(POOL_WINDOWS)
FOURIER_GROUPS = 4
FOURIER_GROUP = BRANCH_WIDTH // FOURIER_GROUPS
RET_HEADS = 4
RET_HEAD_DIM = BRANCH_WIDTH // RET_HEADS
RET_CHUNK = 128
ROPE_BASE = 10000.0
NA_HEADS = 8
NA_HEAD_DIM = BRANCH_WIDTH // NA_HEADS
NA_ROWS_MAX = 8
NA_COLS = 16
D_FF = 5632
EPS = 1e-6
NEG_INF = -1e30
OFF_POOL = 0
OFF_FOURIER = OFF_POOL + BRANCH_WIDTH
OFF_RET = OFF_FOURIER + BRANCH_WIDTH
OFF_NA = OFF_RET + 4 * BRANCH_WIDTH
IN_WIDTH = OFF_NA + 3 * BRANCH_WIDTH

kernel_name = 'hybrid_gated_bidir_encoder'


def rmsnorm(x, g):
    xf = x.astype(jnp.float32)
    y = xf * lax.rsqrt(jnp.mean(xf * xf, axis=-1, keepdims=True) + EPS)
    return (y * g.astype(jnp.float32)).astype(x.dtype)


def head_groupnorm(o):
    mu = jnp.mean(o, axis=-1, keepdims=True)
    var = jnp.mean(jnp.square(o - mu), axis=-1, keepdims=True)
    return (o - mu) * lax.rsqrt(var + EPS)


def rope(x):
    T = x.shape[1]
    half = x.shape[-1] // 2
    inv = ROPE_BASE ** (-jnp.arange(half, dtype=jnp.float32) / half)
    ang = jnp.arange(T, dtype=jnp.float32)[:, None] * inv[None, :]
    cos = jnp.cos(ang)[None, :, None, :]
    sin = jnp.sin(ang)[None, :, None, :]
    x1, x2 = x[..., :half], x[..., half:]
    return jnp.concatenate([x1 * cos - x2 * sin, x1 * sin + x2 * cos], axis=-1)


def centred_pool_minus_self(x, window):
    B, T, C = x.shape
    S = jnp.concatenate([jnp.zeros((B, 1, C), jnp.float32), jnp.cumsum(x, axis=1)], axis=1)
    t = jnp.arange(T)
    lo = jnp.clip(t - window // 2, 0, T)
    hi = jnp.clip(t + window // 2, 0, T)
    count = (hi - lo).astype(jnp.float32)
    return (S[:, hi] - S[:, lo]) / count[None, :, None] - x


def retention_one_direction(q, k, v, log_gamma, strict):
    B, T, H, d = q.shape
    C = RET_CHUNK
    N = T // C
    qc = q.reshape(B, N, C, H, d)
    kc = k.reshape(B, N, C, H, d)
    vc = v.reshape(B, N, C, H, d)
    i = jnp.arange(C, dtype=jnp.float32)
    diff = i[:, None] - i[None, :]
    mask = diff > 0 if strict else diff >= 0
    dmat = jnp.where(mask[None], jnp.exp(log_gamma[:, None, None] * jnp.maximum(diff, 0.0)[None]), 0.0)
    s = jnp.einsum('bnihd,bnjhd->bnhij', qc, kc) * dmat[None, None]
    inner = jnp.einsum('bnhij,bnjhe->bnihe', s, vc)
    k_dec = kc * jnp.exp((C - 1 - i)[:, None] * log_gamma[None, :])[None, None, :, :, None]
    kv = jnp.einsum('bnjhd,bnjhe->nbhde', k_dec, vc)
    chunk_decay = jnp.exp(log_gamma * C)[None, :, None, None]

    def step(R, kv_n):
        return chunk_decay * R + kv_n, R

    _, R_prev = lax.scan(step, jnp.zeros((B, H, d, d), jnp.float32), kv)
    q_dec = qc * jnp.exp((i + 1.0)[:, None] * log_gamma[None, :])[None, None, :, :, None]
    cross = jnp.einsum('bnihd,nbhde->bnihe', q_dec, R_prev)
    return (inner + cross).reshape(B, T, H, d)


def bidir_retention(q, k, v, log_gamma_f, log_gamma_b):
    fwd = retention_one_direction(q, k, v, log_gamma_f, False)
    bwd = retention_one_direction(q[:, ::-1], k[:, ::-1], v[:, ::-1], log_gamma_b, True)[:, ::-1]
    return fwd + bwd


def neighbourhood_attention(q, k, v, rpb):
    B, T, H, dh = q.shape
    rows = T // GRID_W
    kr = min(NA_ROWS_MAX, rows)
    r = jnp.arange(rows)
    col = jnp.arange(GRID_W)
    rs = jnp.clip(r - kr // 2, 0, rows - kr)
    idx_r = rs[:, None] + jnp.arange(kr)[None, :]
    cs = jnp.clip(col - NA_COLS // 2, 0, GRID_W - NA_COLS)
    in_win = (col[None, :] >= cs[:, None]) & (col[None, :] < cs[:, None] + NA_COLS)
    dr = idx_r - r[:, None] + (NA_ROWS_MAX - 1)
    dc = jnp.clip(col[None, :] - col[:, None], -(NA_COLS - 1), NA_COLS - 1) + (NA_COLS - 1)
    bias = rpb[:, dr[:, None, :, None], dc[None, :, None, :]]
    qg = q.reshape(B, rows, GRID_W, H, dh) * (dh ** -0.5)
    kg = k.reshape(B, rows, GRID_W, H, dh)[:, idx_r]
    vg = v.reshape(B, rows, GRID_W, H, dh)[:, idx_r]
    s = jnp.einsum('brqhd,brimhd->bhrqim', qg, kg).astype(jnp.float32) + bias.astype(jnp.float32)[None]
    s = jnp.where(in_win[:, None, :], s, NEG_INF)
    p = jax.nn.softmax(s.reshape(B, H, rows, GRID_W, kr * GRID_W), axis=-1).reshape(s.shape).astype(v.dtype)
    o = jnp.einsum('bhrqim,brimhd->brqhd', p, vg)
    return o.reshape(B, T, H * dh)


def token_mixer(h, w_in, pool_w, pool_scale, decay_f, decay_b, rpb, w_branch, w_gate, b_gate, w_out):
    B, T, _ = h.shape
    W = BRANCH_WIDTH
    p = h @ w_in
    a = p[..., OFF_POOL:OFF_POOL + W].astype(jnp.float32)
    pooled = jnp.concatenate(
        [centred_pool_minus_self(a[..., gi * POOL_GROUP:(gi + 1) * POOL_GROUP], w) for gi, w in enumerate(POOL_WINDOWS)],
        axis=-1).astype(h.dtype).reshape(B, T, len(POOL_WINDOWS), POOL_GROUP)
    br_pool = jnp.einsum('btgc,gce->btge', pooled, pool_w).reshape(B, T, W) * pool_scale
    f = p[..., OFF_FOURIER:OFF_FOURIER + W].astype(jnp.float32).reshape(B, T, FOURIER_GROUPS, FOURIER_GROUP)
    br_fourier = jnp.fft.fftn(f, axes=(1, 3), norm='ortho').real.reshape(B, T, W).astype(h.dtype)
    rr = p[..., OFF_RET:OFF_RET + 4 * W].astype(jnp.float32).reshape(B, T, 4, RET_HEADS, RET_HEAD_DIM)
    q = rope(rr[:, :, 0])
    k = rope(rr[:, :, 1]) * (RET_HEAD_DIM ** -0.5)
    v = rr[:, :, 2]
    g = rr[:, :, 3].reshape(B, T, W)
    o = bidir_retention(q, k, v, jax.nn.log_sigmoid(decay_f.astype(jnp.float32)),
                        jax.nn.log_sigmoid(decay_b.astype(jnp.float32)))
    br_ret = (head_groupnorm(o).reshape(B, T, W) * jax.nn.silu(g)).astype(h.dtype)
    nq = p[..., OFF_NA:OFF_NA + 3 * W].reshape(B, T, 3, NA_HEADS, NA_HEAD_DIM)
    br_na = neighbourhood_attention(nq[:, :, 0], nq[:, :, 1], nq[:, :, 2], rpb)
    gates = jax.nn.sigmoid((h @ w_gate + b_gate).astype(jnp.float32)).astype(h.dtype).reshape(B, T, N_BRANCH, D_MODEL)
    branches = (br_pool, br_fourier, br_ret, br_na)
    merged = gates[:, :, 0] * (branches[0] @ w_branch[0])
    for bi in range(1, N_BRANCH):
        merged = merged + gates[:, :, bi] * (branches[bi] @ w_branch[bi])
    return merged @ w_out


def dwconv3(u, w, b):
    up = jnp.pad(u, ((0, 0), (1, 1), (0, 0)))
    return up[:, :-2] * w[0] + up[:, 1:-1] * w[1] + up[:, 2:] * w[2] + b


def conv_ffn(h, w_up, conv_w, conv_b, w_down):
    u = dwconv3(h @ w_up, conv_w, conv_b)
    a, b = jnp.split(u, 2, axis=-1)
    return (jax.nn.gelu(a, approximate=True) * b) @ w_down


def encoder_trunk(x, c, w_ada, b_ada, g_mix, w_in, pool_w, pool_scale, ret_decay_f, ret_decay_b, na_rpb,
                  w_branch, w_gate, b_gate, w_out, g_ffn, w_up, conv_w, conv_b, w_down, g_final):
    for l in range(DEPTH):
        mod = (jax.nn.silu(c) @ w_ada[l] + b_ada[l])[:, None, :]
        shift1, scale1, gate1, shift2, scale2, gate2 = jnp.split(mod, 6, axis=-1)
        h = rmsnorm(x, g_mix[l]) * (1.0 + scale1) + shift1
        x = x + gate1 * token_mixer(h, w_in[l], pool_w[l], pool_scale[l], ret_decay_f[l], ret_decay_b[l],
                                    na_rpb[l], w_branch[l], w_gate[l], b_gate[l], w_out[l])
        h = rmsnorm(x, g_ffn[l]) * (1.0 + scale2) + shift2
        x = x + gate2 * conv_ffn(h, w_up[l], conv_w[l], conv_b[l], w_down[l])
    return rmsnorm(x, g_final)


def setup_inputs(seed: int = 0) -> dict:
    key = jax.random.key(seed)
    ks = jax.random.split(key, 24)

    def nrm(k, shape, s):
        return jax.random.normal(k, shape, jnp.float32) * s

    g0 = 1.0 - 2.0 ** (-5.0 - jnp.arange(RET_HEADS, dtype=jnp.float32))
    decay_logit = jnp.log(g0) - jnp.log1p(-g0)
    return {
        'x_prompt': nrm(ks[0], (BATCH, SEQ, D_MODEL), 1.0),
        'x_sample': nrm(ks[1], (DEC_BATCH, DEC_SEQ, D_MODEL), 1.0),
        'c_prompt': nrm(ks[2], (BATCH, D_MODEL), 1.0),
        'c_sample': nrm(ks[3], (DEC_BATCH, D_MODEL), 1.0),
        'w_ada': nrm(ks[4], (DEPTH, D_MODEL, 6 * D_MODEL), 0.5 * D_MODEL ** -0.5),
        'b_ada': nrm(ks[5], (DEPTH, 6 * D_MODEL), 0.02),
        'g_mix': 1.0 + nrm(ks[6], (DEPTH, D_MODEL), 0.02),
        'w_in': nrm(ks[7], (DEPTH, D_MODEL, IN_WIDTH), D_MODEL ** -0.5),
        'pool_w': nrm(ks[8], (DEPTH, len(POOL_WINDOWS), POOL_GROUP, POOL_GROUP), POOL_GROUP ** -0.5),
        'pool_scale': 1.0 + nrm(ks[9], (DEPTH, BRANCH_WIDTH), 0.1),
        'ret_decay_f': decay_logit[None, :] + nrm(ks[10], (DEPTH, RET_HEADS), 0.05),
        'ret_decay_b': decay_logit[None, :] + nrm(ks[11], (DEPTH, RET_HEADS), 0.05),
        'na_rpb': nrm(ks[12], (DEPTH, NA_HEADS, 2 * NA_ROWS_MAX - 1, 2 * NA_COLS - 1), 0.02),
        'w_branch': nrm(ks[13], (DEPTH, N_BRANCH, BRANCH_WIDTH, D_MODEL), BRANCH_WIDTH ** -0.5),
        'w_gate': nrm(ks[14], (DEPTH, D_MODEL, N_BRANCH * D_MODEL), D_MODEL ** -0.5),
        'b_gate': nrm(ks[15], (DEPTH, N_BRANCH * D_MODEL), 0.02),
        'w_out': nrm(ks[16], (DEPTH, D_MODEL, D_MODEL), D_MODEL ** -0.5),
        'g_ffn': 1.0 + nrm(ks[17], (DEPTH, D_MODEL), 0.02),
        'w_up': nrm(ks[18], (DEPTH, D_MODEL, 2 * D_FF), D_MODEL ** -0.5),
        'conv_w': nrm(ks[19], (DEPTH, 3, 2 * D_FF), 3.0 ** -0.5),
        'conv_b': nrm(ks[20], (DEPTH, 2 * D_FF), 0.02),
        'w_down': nrm(ks[21], (DEPTH, D_FF, D_MODEL), D_FF ** -0.5),
        'g_final': 1.0 + nrm(ks[22], (D_MODEL,), 0.02),
    }


def reference(x_prompt, x_sample, c_prompt, c_sample, w_ada, b_ada, g_mix, w_in, pool_w, pool_scale,
              ret_decay_f, ret_decay_b, na_rpb, w_branch, w_gate, b_gate, w_out, g_ffn, w_up, conv_w,
              conv_b, w_down, g_final):
    y_prompt = encoder_trunk(x_prompt, c_prompt, w_ada, b_ada, g_mix, w_in, pool_w, pool_scale, ret_decay_f,
                             ret_decay_b, na_rpb, w_branch, w_gate, b_gate, w_out, g_ffn, w_up, conv_w,
                             conv_b, w_down, g_final)
    y_sample = encoder_trunk(x_sample, c_sample, w_ada, b_ada, g_mix, w_in, pool_w, pool_scale, ret_decay_f,
                             ret_decay_b, na_rpb, w_branch, w_gate, b_gate, w_out, g_ffn, w_up, conv_w,
                             conv_b, w_down, g_final)
    return (y_prompt, y_sample)
```

```cpp
#include <hip/hip_runtime.h>
#include <cstdio>
#include <cstdint>

#define LAS __attribute__((address_space(3)))
typedef unsigned short bf16_t;
typedef short bf16x8 __attribute__((ext_vector_type(8)));
typedef short bf16x4 __attribute__((ext_vector_type(4)));
typedef float f32x4 __attribute__((ext_vector_type(4)));
typedef float f32x2 __attribute__((ext_vector_type(2)));
typedef unsigned u32x4 __attribute__((ext_vector_type(4)));
typedef unsigned u32x2 __attribute__((ext_vector_type(2)));

#ifndef REP_MIX
#define REP_MIX 1
#endif
#ifndef REP_ELT
#define REP_ELT 1
#endif
#ifndef REP_DFT
#define REP_DFT 1
#endif
#ifndef REP_G1
#define REP_G1 1
#endif
#ifndef REP_UP
#define REP_UP 1
#endif
#define REPEAT(n) _Pragma("unroll 1") for (int r_ = 0; r_ < (n); ++r_)
#ifndef MK_N_LAUNCHES
#define MK_N_LAUNCHES 1
#endif

constexpr int D = 2048, DEPTH = 4, NSEQ = 4, MTOK = 24576;
constexpr int INW = 4608, DFF = 5632, NUP = 11264, NGATE = 8192;
constexpr int NWAVES = 8, NTHREADS = 512;
constexpr int LDS_BYTES = 163840, LDS_MISC = LDS_BYTES - 256;
constexpr float EPS = 1e-6f;

__host__ __device__ __forceinline__ int seq_start(int s) { return s < 2 ? s * 8192 : 16384 + (s - 2) * 4096; }
__host__ __device__ __forceinline__ int seq_len(int s) { return s < 2 ? 8192 : 4096; }
__host__ __device__ __forceinline__ int seq_of_row(int m) { return m < 16384 ? (m >> 13) : 2 + ((m - 16384) >> 12); }

constexpr size_t MiB = 1u << 20;
constexpr size_t WS_CTL = 0, CTL_ZERO_BYTES = 1 * MiB, WS_ZERO = 512 * 1024;
constexpr size_t WS_MOD = 1 * MiB;
constexpr size_t WS_MODP = 1318 * MiB;
constexpr size_t WS_ROPEC = 8 * MiB, WS_ROPES = 10 * MiB, WS_ROPECT = 12 * MiB, WS_ROPEST = 14 * MiB;
constexpr size_t WS_D2 = 16 * MiB;
constexpr size_t WS_A1 = WS_D2 + 256 * 1024;
constexpr size_t WS_A2L = WS_D2 + 512 * 1024;
constexpr size_t WS_A2S = WS_D2 + 640 * 1024;
constexpr size_t WS_TWL = WS_D2 + 768 * 1024;
constexpr size_t WS_TWS = WS_D2 + 896 * 1024;
constexpr size_t WS_ZT = 18 * MiB;
constexpr size_t WS_W1T = 274 * MiB;
constexpr size_t WS_WBRT = 324 * MiB;
constexpr size_t WS_WOUTT = 332 * MiB;
constexpr size_t WS_WUPT = 340 * MiB;
constexpr size_t WS_WDNT = 384 * MiB;
constexpr size_t WS_H = 406 * MiB;
constexpr size_t WS_P = 502 * MiB;
constexpr size_t WS_PT = 718 * MiB;
constexpr size_t WS_GATES = 790 * MiB;
constexpr size_t WS_BR = 1174 * MiB;
constexpr size_t WS_YT = 1270 * MiB;
constexpr size_t WS_KV = 1318 * MiB;
constexpr size_t WS_RT = 1414 * MiB;
constexpr size_t WS_MERGED = 1270 * MiB;
constexpr size_t WS_Y = 502 * MiB;
constexpr size_t WS_ACT = 1030 * MiB;
constexpr size_t WS_XB = 1462 * MiB;
constexpr size_t WS_END = 1558 * MiB;

typedef __bf16 bf16x2v __attribute__((ext_vector_type(2)));
__device__ __forceinline__ unsigned cvt_pk_bf16(float lo, float hi) { const f32x2 v = {lo, hi}; const bf16x2v b = __builtin_convertvector(v, bf16x2v); return __builtin_bit_cast(unsigned, b); }
__device__ __forceinline__ float bf2f(unsigned short b) { return __uint_as_float(((unsigned)b) << 16); }
__device__ __forceinline__ float bflo(unsigned w) { return __uint_as_float(w << 16); }
__device__ __forceinline__ float bfhi(unsigned w) { return __uint_as_float(w & 0xffff0000u); }
__device__ __forceinline__ float wave_sum(float v) {
#pragma unroll
    for (int o = 1; o < 64; o <<= 1) v += __shfl_xor(v, o);
    return v;
}
__device__ __forceinline__ float fast_exp(float x) { return __builtin_amdgcn_exp2f(x * 1.4426950408889634f); }
__device__ __forceinline__ float fast_rcp(float x) { return __builtin_amdgcn_rcpf(x); }
__device__ __forceinline__ float sigmoidf_(float x) { return fast_rcp(1.0f + fast_exp(-x)); }
constexpr float NLOG2E = -1.4426950408889634f;
__device__ __forceinline__ float sig2_(float t) { return fast_rcp(1.0f + __builtin_amdgcn_exp2f(t)); }
__device__ __forceinline__ float gelu_tanh(float u) { const float a = u * (u * u * 0.10294324f + 2.3022082f); const float r = fast_rcp(1.0f + __builtin_amdgcn_exp2f(a)); return u - u * r; }
__device__ __forceinline__ float dpp_ror1(float v) { return __builtin_bit_cast(float, __builtin_amdgcn_mov_dpp(__builtin_bit_cast(int, v), 0x121, 0xf, 0xf, false)); }
__device__ __forceinline__ float dpp_ror15(float v) { return __builtin_bit_cast(float, __builtin_amdgcn_mov_dpp(__builtin_bit_cast(int, v), 0x12f, 0xf, 0xf, false)); }
__device__ __forceinline__ f32x4 mfma16(bf16x8 a, bf16x8 b, f32x4 c) { return __builtin_amdgcn_mfma_f32_16x16x32_bf16(a, b, c, 0, 0, 0); }

#define SCHED_FENCE() __builtin_amdgcn_sched_barrier(0)
#define XB_TMO      128
#define XB_XCNT(j)  (256  + 64 * (j))
#define XB_XSUB(j)  (1280 + 64 * (j))
#define XB_XGEN(j)  (2304 + 64 * (j))
#define XB_TOP      3328
#define XB_TOPGEN   3392
#define XCD_BAR_WORDS 3456
#define XB_SPIN_CAP (1u << 22)

__device__ __forceinline__ unsigned xb_ld(unsigned* p)              { return __hip_atomic_load(p, __ATOMIC_RELAXED, __HIP_MEMORY_SCOPE_AGENT); }
__device__ __forceinline__ unsigned xb_add(unsigned* p, unsigned v) { return __hip_atomic_fetch_add(p, v, __ATOMIC_RELAXED, __HIP_MEMORY_SCOPE_AGENT); }
__device__ __forceinline__ unsigned xb_xcc_id() { return (unsigned)__builtin_amdgcn_s_getreg((3 << 11) | 20) & 0xFu; }
#define XB_SPIN(cond, bar) do { unsigned _sp = 0; while (cond) { __builtin_amdgcn_s_sleep(1); \
    if ((++_sp & 255u) == 0u) { if (xb_ld(&(bar)[XB_TMO])) break; if (_sp > XB_SPIN_CAP) { atomicAdd(&(bar)[XB_TMO], 1u); break; } } } } while (0)

struct XcdBarrier {
    unsigned* bar; unsigned x;
    volatile LAS unsigned* st;
};
__device__ __forceinline__ XcdBarrier xcd_barrier_post(unsigned* bar, volatile LAS unsigned* st) {
    XcdBarrier b; b.bar = bar; b.x = xb_xcc_id(); b.st = st;
    if (threadIdx.x == 0) (void)xb_add(&bar[XB_XCNT(b.x)], 1u);
    return b;
}
__device__ __forceinline__ void xcd_barrier_complete(unsigned* bar, unsigned x, unsigned& nloc, unsigned& nx) {
    const unsigned G = gridDim.x * gridDim.y * gridDim.z;
    unsigned sum, cnt, mine, sp = 0u;
    for (;;) {
        sum = 0u; cnt = 0u; mine = 0u;
#pragma unroll
        for (unsigned j = 0; j < 16; ++j) { const unsigned c = xb_ld(&bar[XB_XCNT(j)]); sum += c; cnt += (c > 0u) ? 1u : 0u; mine = (j == x) ? c : mine; }
        if (sum == G) break;
        __builtin_amdgcn_s_sleep(1);
        if ((++sp & 255u) == 0u) { if (xb_ld(&bar[XB_TMO])) break; if (sp > XB_SPIN_CAP) { atomicAdd(&bar[XB_TMO], 1u); break; } }
    }
    nloc = mine > 0u ? mine : 1u; nx = cnt > 0u ? cnt : 1u;
}
__device__ __forceinline__ void xcd_barrier(const XcdBarrier& b) {
    asm volatile("s_waitcnt vmcnt(0)" ::: "memory");
    __syncthreads();
    if (threadIdx.x == 0) {
        unsigned* bar = b.bar;
        __builtin_amdgcn_s_waitcnt(0);
        unsigned nloc = b.st[0], nx = b.st[1];
        if (nloc == 0u) { xcd_barrier_complete(bar, b.x, nloc, nx); b.st[0] = nloc; b.st[1] = nx; }
        const unsigned old = xb_add(&bar[XB_XSUB(b.x)], 1u);
        const unsigned gen = old / nloc;
        if (old + 1u == (gen + 1u) * nloc) {
            __builtin_amdgcn_fence(__ATOMIC_RELEASE, "agent");
            asm volatile("s_waitcnt vmcnt(0)" ::: "memory");
            const unsigned og = xb_add(&bar[XB_TOP], 1u);
            const unsigned tg = og / nx;
            if (og + 1u == (tg + 1u) * nx) xb_add(&bar[XB_TOPGEN], 1u);
            else XB_SPIN(xb_ld(&bar[XB_TOPGEN]) == tg, bar);
            __builtin_amdgcn_fence(__ATOMIC_ACQUIRE, "agent");
            xb_add(&bar[XB_XGEN(b.x)], 1u);
            asm volatile("s_waitcnt vmcnt(0)" ::: "memory");
        } else {
            XB_SPIN(xb_ld(&bar[XB_XGEN(b.x)]) == gen, bar);
            __builtin_amdgcn_fence(__ATOMIC_ACQUIRE, "agent");
            asm volatile("s_waitcnt vmcnt(0)" ::: "memory");
        }
    }
    __syncthreads();
}

namespace pg8 {
constexpr int BM = 256, BK = 64, HALF = 128, HTB = HALF * BK * 2, STAGE_BYTES = 8 * HTB, NXCD = 8, WGM = 8;
__host__ __device__ __forceinline__ int lds_byte(int r, int c) { const int st = (r >> 4) * 2 + (c >> 5), rr = r & 15, cc = c & 31, ob = rr * 64 + cc * 2; return st * 1024 + (ob ^ (((ob >> 9) & 1) << 5)); }
__host__ __device__ __forceinline__ void stage_rc(int b, int& R, int& C) { const int st = b / 1024, sb = b % 1024, swz = sb ^ (((sb >> 9) & 1) << 5); R = (st >> 1) * 16 + swz / 64; C = (st & 1) * 32 + (swz % 64) / 2; }
__host__ __device__ __forceinline__ int perm32(int rho) { const int n = rho >> 4, i = rho & 15; return 8 * (i >> 2) + 4 * n + (i & 3); }

struct Unit { const char* A; const char* B; int nt, kind, r0, c0, dst; };
__device__ __forceinline__ bool tile_order(int i, int G, int c, int nM, int nN, int& pm, int& pn) {
    const int nwg = nM * nN; const long L = (long)i * G + c; if (L >= nwg) return false;
    int wgid = (int)L; { const int q = nwg / NXCD, r = nwg % NXCD, xcd = wgid % NXCD, off = wgid / NXCD; wgid = (xcd < r ? xcd * (q + 1) : r * (q + 1) + (xcd - r) * q) + off; }
    const int nig = WGM * nN, gid = wgid / nig, fm = gid * WGM, gsz = (nM - fm) < WGM ? (nM - fm) : WGM;
    pm = fm + ((wgid % nig) % gsz); pn = (wgid % nig) / gsz; return true;
}

template <class Epi, class Sched>
__device__ __forceinline__ void gemm_phase(LAS unsigned char* lds, const int tid, const unsigned lda, const unsigned ldb, const size_t hstepA, const size_t hstepB, const Sched& S, const Epi& E) {
    const int wid = __builtin_amdgcn_readfirstlane(tid >> 6), lane = tid & 63, wr = wid >> 2, wc = wid & 3, fr = lane & 15, fq = lane >> 4;
    unsigned voffA[2], voffB[2];
#pragma unroll
    for (int i = 0; i < 2; ++i) { int R, C; stage_rc(tid * 16 + i * 8192, R, C); const int Rb = Epi::PERM ? ((R & ~31) + perm32(R & 31)) : R;
        const int Ra = Epi::APERM ? ((R & ~63) + 4 * (R & 15) + ((R >> 4) & 3)) : R;
        voffA[i] = (unsigned)Ra * lda + (unsigned)C * 2u; voffB[i] = (unsigned)Rb * ldb + (unsigned)C * 2u; }
    const size_t kstep = (size_t)(BK * 2);
    const unsigned ldsw = (unsigned)wid * 1024u;
    const int aoff = lds_byte(wr * 64 + fr, fq * 8), boff = lds_byte(wc * 32 + fr, fq * 8);
#define PG8_SA(b, h) (((b) * 2 + (h)) * HTB)
#define PG8_SB(b, h) ((4 + (b) * 2 + (h)) * HTB)
#define PG8_STAGE(bufoff, gbase, voff) do { _Pragma("unroll") for (int _i = 0; _i < 2; ++_i) \
        __builtin_amdgcn_global_load_lds((const unsigned*)((const char*)(gbase) + (voff)[_i]), (LAS unsigned*)(lds + (bufoff) + ldsw + _i * 8192), 16, 0, 0); } while (0)
#define PG8_LDA(dst, b, h) do { _Pragma("unroll") for (int m = 0; m < 4; ++m) _Pragma("unroll") for (int k = 0; k < 2; ++k) dst[m][k] = *(const LAS bf16x8*)(lds + PG8_SA(b, h) + aoff + m * 2048 + k * 1024); } while (0)
#define PG8_LDB(dst, b, h) do { _Pragma("unroll") for (int n = 0; n < 2; ++n) _Pragma("unroll") for (int k = 0; k < 2; ++k) dst[n][k] = *(const LAS bf16x8*)(lds + PG8_SB(b, h) + boff + n * 2048 + k * 1024); } while (0)
#define PG8_MMA(ai, bj, At, Bt) do { __builtin_amdgcn_s_setprio(1); _Pragma("unroll") for (int m = 0; m < 4; ++m) _Pragma("unroll") for (int n = 0; n < 2; ++n) _Pragma("unroll") for (int k = 0; k < 2; ++k) \
        acc[ai][bj][m][n] = __builtin_amdgcn_mfma_f32_16x16x32_bf16(Bt[n][k], At[m][k], acc[ai][bj][m][n], 0, 0, 0); __builtin_amdgcn_s_setprio(0); } while (0)
#ifdef DBG_DRAIN
#define PG8_WAIT_V(n) asm volatile("s_waitcnt vmcnt(0)" ::: "memory")
#else
#define PG8_WAIT_V(n) asm volatile("s_waitcnt vmcnt(" #n ")" ::: "memory")
#endif
#define PG8_WAIT_L(n) asm volatile("s_waitcnt lgkmcnt(" #n ")" ::: "memory")
#define PG8_BAR __builtin_amdgcn_s_barrier()
#define PG8_SCHED __builtin_amdgcn_sched_barrier(0)
    Unit cur, nxt; int ui = 0;
    if (!S.next(0, cur)) return;
    f32x4 acc[2][2][4][2];
#pragma unroll
    for (int a = 0; a < 2; ++a)
#pragma unroll
        for (int b = 0; b < 2; ++b)
#pragma unroll
            for (int m = 0; m < 4; ++m)
#pragma unroll
                for (int n = 0; n < 2; ++n) acc[a][b][m][n] = (f32x4){0.f, 0.f, 0.f, 0.f};
    bf16x8 At[4][2], B0[2][2], B1[2][2];
    const char* cA = cur.A; const char* cB = cur.B;
    PG8_STAGE(PG8_SB(0, 0), cB, voffB); PG8_STAGE(PG8_SB(0, 1), cB + hstepB, voffB); PG8_STAGE(PG8_SA(0, 0), cA, voffA); PG8_STAGE(PG8_SA(0, 1), cA + hstepA, voffA);
    if (wr == 1) PG8_BAR;
    PG8_WAIT_V(2); PG8_BAR;
    PG8_STAGE(PG8_SB(1, 0), cB + kstep, voffB); PG8_STAGE(PG8_SA(1, 0), cA + kstep, voffA); PG8_STAGE(PG8_SB(1, 1), cB + hstepB + kstep, voffB);
    PG8_WAIT_V(6); PG8_BAR;
    for (;;) {
        const bool has_next = S.next(ui + 1, nxt);
        const char* nA = has_next ? nxt.A : cA; const char* nB = has_next ? nxt.B : cB;
        if constexpr (Epi::PRE) { cur.dst = (ui & 1) * 4096; E.pre(cur, tid); }
        int nt = cur.nt; asm volatile("" : "+s"(nt));
        for (int t = 0; t < nt; t += 2) {
            const bool last = (t == nt - 2);
            const char* a1 = cA + (size_t)(t + 1) * kstep;
            const char* a2 = last ? nA : cA + (size_t)(t + 2) * kstep; const char* b2 = last ? nB : cB + (size_t)(t + 2) * kstep;
            const char* a3 = a2 + kstep; const char* b3 = b2 + kstep;
            PG8_LDB(B0, 0, 0); PG8_LDB(B1, 0, 1); PG8_SCHED; PG8_LDA(At, 0, 0); PG8_STAGE(PG8_SA(1, 1), a1 + hstepA, voffA);
            PG8_WAIT_V(8); PG8_WAIT_L(0); PG8_BAR; PG8_MMA(0, 0, At, B0); PG8_MMA(0, 1, At, B1); PG8_BAR; PG8_SCHED;
            PG8_LDA(At, 0, 1); PG8_STAGE(PG8_SB(0, 0), b2, voffB); PG8_STAGE(PG8_SB(0, 1), b2 + hstepB, voffB); PG8_STAGE(PG8_SA(0, 0), a2, voffA);
            PG8_WAIT_V(8); PG8_WAIT_L(0); PG8_BAR; PG8_MMA(1, 0, At, B0); PG8_MMA(1, 1, At, B1); PG8_BAR; PG8_SCHED;
            PG8_LDB(B0, 1, 0); PG8_LDB(B1, 1, 1); PG8_SCHED; PG8_LDA(At, 1, 0); PG8_STAGE(PG8_SA(0, 1), a2 + hstepA, voffA);
            PG8_WAIT_V(8); PG8_WAIT_L(0); PG8_BAR; PG8_MMA(0, 0, At, B0); PG8_MMA(0, 1, At, B1); PG8_BAR; PG8_SCHED;
            PG8_LDA(At, 1, 1); PG8_STAGE(PG8_SB(1, 0), b3, voffB); PG8_STAGE(PG8_SB(1, 1), b3 + hstepB, voffB); PG8_STAGE(PG8_SA(1, 0), a3, voffA);
            PG8_WAIT_V(8); PG8_WAIT_L(0); PG8_BAR; PG8_MMA(1, 0, At, B0); PG8_MMA(1, 1, At, B1); PG8_BAR; PG8_SCHED;
        }
        if (wr == 0) PG8_BAR;
        { int fr_ = fr, fq_ = fq, wr_ = wr, wc_ = wc; asm volatile("" : "+v"(fr_), "+v"(fq_), "+s"(wr_), "+s"(wc_)); E(acc, cur, wr_, wc_, fr_, fq_); }
        if (!has_next) break;
#pragma unroll
        for (int a = 0; a < 2; ++a)
#pragma unroll
            for (int b = 0; b < 2; ++b)
#pragma unroll
                for (int m = 0; m < 4; ++m)
#pragma unroll
                    for (int n = 0; n < 2; ++n) acc[a][b][m][n] = (f32x4){0.f, 0.f, 0.f, 0.f};
        cur = nxt; cA = nA; cB = nB; ++ui;
        if (wr == 1) PG8_BAR;
    }
    PG8_WAIT_V(0);
    PG8_BAR;
#undef PG8_SA
#undef PG8_SB
#undef PG8_STAGE
#undef PG8_LDA
#undef PG8_LDB
#undef PG8_MMA
#undef PG8_WAIT_V
#undef PG8_WAIT_L
#undef PG8_BAR
#undef PG8_SCHED
}
}
using pg8::Unit;
typedef f32x4 Acc[2][2][4][2];

__device__ __forceinline__ u32x4 pack8(const f32x4 v0, const f32x4 v1) { u32x4 w; w.x = cvt_pk_bf16(v0[0], v0[1]); w.y = cvt_pk_bf16(v0[2], v0[3]); w.z = cvt_pk_bf16(v1[0], v1[1]); w.w = cvt_pk_bf16(v1[2], v1[3]); return w; }

__device__ __forceinline__ size_t gate_frag_off(int pm, int gct, int ai, int m, int bj, int wave, int lane) { return ((size_t)(pm * 32 + gct) << 16) + (size_t)(((((ai * 4 + m) * 2 + bj) * 8 + wave) * 64 + lane) * 8); }
struct EpiG1 {
    static constexpr bool PERM = true, PRE = false, APERM = false;
    bf16_t* P; bf16_t* PT; bf16_t* GATES; const float* bgate; const float* ropeC; const float* ropeS; const float* ropeCT; const float* ropeST;
    __device__ __forceinline__ void operator()(const Acc& acc, const Unit& u, int wr, int wc, int fr, int fq) const {
        const int ct0 = wc * 32 + 8 * fq;
        if (u.kind == 0) {
#pragma unroll
            for (int ai = 0; ai < 2; ++ai)
#pragma unroll
                for (int m = 0; m < 4; ++m) { bf16_t* rowp = P + (size_t)(u.r0 + ai * 128 + wr * 64 + m * 16 + fr) * INW + u.dst + ct0;
#pragma unroll
                    for (int bj = 0; bj < 2; ++bj) *(u32x4*)(rowp + bj * 128) = pack8(acc[ai][bj][m][0], acc[ai][bj][m][1]); }
        } else if (u.kind == 2) {
            f32x4 bv[2][2];
#pragma unroll
            for (int bj = 0; bj < 2; ++bj) { bv[bj][0] = *(const f32x4*)(bgate + u.dst + ct0 + bj * 128) * NLOG2E; bv[bj][1] = *(const f32x4*)(bgate + u.dst + ct0 + bj * 128 + 4) * NLOG2E; }
            SCHED_FENCE();
#pragma unroll
            for (int bj = 0; bj < 2; ++bj)
#pragma unroll
                for (int ai = 0; ai < 2; ++ai)
#pragma unroll
                    for (int m = 0; m < 4; ++m) { bf16_t* rowp = GATES + gate_frag_off(u.r0 >> 8, u.dst >> 8, ai, m, bj, wr * 4 + wc, fq * 16 + fr);
                        __builtin_nontemporal_store(pack8(acc[ai][bj][m][0] * NLOG2E + bv[bj][0], acc[ai][bj][m][1] * NLOG2E + bv[bj][1]), (u32x4*)(rowp)); }
        } else if (u.kind == 1) {
            const int s = seq_of_row(u.r0), pos0 = u.r0 - seq_start(s);
            const float sc = (u.c0 != 0) ? 0.08838834764831845f : 1.0f;
            const int hl = wc >> 1, jd0 = 32 * (wc & 1) + 8 * fq;
#pragma unroll
            for (int ai = 0; ai < 2; ++ai) { f32x4 cv[4][2], sv[4][2];
#pragma unroll
                for (int m = 0; m < 4; ++m) { const int pos = pos0 + ai * 128 + wr * 64 + m * 16 + fr;
#pragma unroll
                    for (int n = 0; n < 2; ++n) { cv[m][n] = *(const f32x4*)(ropeC + (size_t)pos * 64 + jd0 + 4 * n); sv[m][n] = *(const f32x4*)(ropeS + (size_t)pos * 64 + jd0 + 4 * n); } }
                SCHED_FENCE();
#pragma unroll
                for (int m = 0; m < 4; ++m) { const int rt = ai * 128 + wr * 64 + m * 16 + fr; bf16_t* rowp = P + (size_t)(u.r0 + rt) * INW + u.dst + hl * 128 + jd0;
#pragma unroll
                    for (int n = 0; n < 2; ++n) { const f32x4 x1 = acc[ai][0][m][n], x2 = acc[ai][1][m][n]; const f32x4 o1 = (x1 * cv[m][n] - x2 * sv[m][n]) * sc, o2 = (x1 * sv[m][n] + x2 * cv[m][n]) * sc;
                        u32x2 w1, w2; w1.x = cvt_pk_bf16(o1[0], o1[1]); w1.y = cvt_pk_bf16(o1[2], o1[3]); w2.x = cvt_pk_bf16(o2[0], o2[1]); w2.y = cvt_pk_bf16(o2[2], o2[3]);
                        *(u32x2*)(rowp + 4 * n) = w1; *(u32x2*)(rowp + 64 + 4 * n) = w2; } }
                SCHED_FENCE(); }
        } else {
#pragma unroll
            for (int ai = 0; ai < 2; ++ai)
#pragma unroll
                for (int m = 0; m < 4; ++m) { bf16_t* rowp = PT + (size_t)(u.dst + ai * 128 + wr * 64 + m * 16 + fr) * MTOK + u.c0 + ct0;
#pragma unroll
                    for (int bj = 0; bj < 2; ++bj) *(u32x4*)(rowp + bj * 128) = pack8(acc[ai][bj][m][0], acc[ai][bj][m][1]); }
        }
    }
};
struct SchedG1 {
    int G, c; const char* H; const char* W1T;
    __device__ __forceinline__ bool next(int i, Unit& u) const {
        int pm, pn; if (!pg8::tile_order(i, G, c, 96, 50, pm, pn)) return false;
        const size_t rowb = 4096;
        u.nt = 32; u.r0 = pm * 256; u.c0 = 0;
        if (pn < 46) {
            u.A = H + (size_t)pm * 256 * rowb;
            if (pn < 14) { u.B = W1T + (size_t)pn * 256 * rowb;
                if (pn >= 4 && pn < 8) { u.kind = 1; u.c0 = (pn >= 6) ? 1 : 0; u.dst = (pn < 6) ? 1024 + (pn - 4) * 256 : 1536 + (pn - 6) * 256; }
                else { u.kind = 0; u.dst = pn < 4 ? pn * 256 : (pn < 10 ? 2560 + (pn - 8) * 256 : (pn < 12 ? 3072 + (pn - 10) * 256 : 3584 + (pn - 12) * 256)); } }
            else { u.B = W1T + (size_t)(4608 + (pn - 14) * 256) * rowb; u.kind = 2; u.dst = (pn - 14) * 256; }
        } else {
            u.B = H + (size_t)pm * 256 * rowb; u.c0 = pm * 256;
            u.A = W1T + (size_t)(3584 + (pn - 46) * 256) * rowb; u.kind = 3; u.dst = 512 + (pn - 46) * 256;
        }
        return true;
    }
};

__device__ __forceinline__ size_t yt_seq_off(int s) { return s < 2 ? (size_t)s * 512 * 64 * 256 : (size_t)2 * 512 * 64 * 256 + (size_t)(s - 2) * 512 * 32 * 256; }
struct EpiCDFT {
    static constexpr bool PERM = false, PRE = false, APERM = false;
    bf16_t* YT;
    __device__ __forceinline__ void operator()(const Acc& acc, const Unit& u, int wr, int wc, int fr, int fq) const {
        const int s = u.kind, N2 = seq_len(s) >> 7; bf16_t* yt = YT + yt_seq_off(s);
#pragma unroll
        for (int m = 0; m < 4; ++m) { const int col = u.dst * 128 + 64 * wr + 16 * m + fr;
#pragma unroll
            for (int bj = 0; bj < 2; ++bj) { bf16_t* rowp = yt + ((size_t)(col * N2 + u.c0 + bj) * 2) * 128 + 32 * wc + 4 * fq;
#pragma unroll
                for (int n = 0; n < 2; ++n) { const f32x4 cv = acc[0][bj][m][n], sv = acc[1][bj][m][n];
                    u32x2 w0, w1; w0.x = cvt_pk_bf16(cv[0], cv[1]); w0.y = cvt_pk_bf16(cv[2], cv[3]); w1.x = cvt_pk_bf16(sv[0], sv[1]); w1.y = cvt_pk_bf16(sv[2], sv[3]);
                    *(u32x2*)(rowp + 16 * n) = w0; *(u32x2*)(rowp + 128 + 16 * n) = w1; } } }
    }
};
struct SchedCDFT {
    int G, c; const char* D2; const char* P; int lng;
    __device__ __forceinline__ bool next(int i, Unit& u) const {
        const int L = i * G + c; int s, bp, g;
        if (lng) { if (L >= 256) return false; s = L >> 7; bp = (L & 127) >> 2; g = L & 3; }
        else { if (L >= 128) return false; s = 2 + (L >> 6); bp = (L & 63) >> 2; g = L & 3; }
        u.A = D2; u.B = P + ((size_t)(seq_start(s) + 2 * bp) * INW + 512 + g * 128) * 2; u.nt = 2; u.kind = s; u.dst = g; u.c0 = 2 * bp; u.r0 = 0; return true;
    }
};
struct EpiF1 {
    static constexpr bool PERM = true, PRE = false, APERM = false;
    bf16_t* ZT; const float* twl; const float* tws;
    __device__ __forceinline__ void operator()(const Acc& acc, const Unit& u, int wr, int wc, int fr, int fq) const {
        const int s = u.kind; const bool lng = s < 2; const int N2 = lng ? 64 : 32, sh = lng ? 6 : 5; const float* tc = lng ? twl : tws; const float* ts = tc + 128 * N2;
        bf16_t* zt = ZT + (size_t)s * 65536 * 128;
#pragma unroll
        for (int mp = 0; mp < 2; ++mp) { f32x4 tcv[2][2][2], tsv[2][2][2];
#pragma unroll
            for (int mm = 0; mm < 2; ++mm) { const int c = 64 * wr + 16 * (2 * mp + mm) + fr;
#pragma unroll
                for (int bj = 0; bj < 2; ++bj) { const int b = (u.c0 + 128 * bj + 32 * wc + 8 * fq) & (N2 - 1);
                    tcv[mm][bj][0] = *(const f32x4*)(tc + c * N2 + b); tcv[mm][bj][1] = *(const f32x4*)(tc + c * N2 + b + 4); tsv[mm][bj][0] = *(const f32x4*)(ts + c * N2 + b); tsv[mm][bj][1] = *(const f32x4*)(ts + c * N2 + b + 4); } }
            SCHED_FENCE();
#pragma unroll
            for (int mm = 0; mm < 2; ++mm) { const int m = 2 * mp + mm, c = 64 * wr + 16 * m + fr;
#pragma unroll
                for (int bj = 0; bj < 2; ++bj) { const int n0 = u.c0 + 128 * bj + 32 * wc + 8 * fq, col = n0 >> sh, b = n0 & (N2 - 1);
                    bf16_t* rowp = zt + ((size_t)c * 512 + col) * 128;
                    const f32x4 c0 = tcv[mm][bj][0], c1 = tcv[mm][bj][1], s0 = tsv[mm][bj][0], s1 = tsv[mm][bj][1];
                    const f32x4 zr0 = acc[0][bj][m][0], zr1 = acc[0][bj][m][1], zi0 = acc[1][bj][m][0], zi1 = acc[1][bj][m][1];
                    *(u32x4*)(rowp + b) = pack8(zr0 * c0 + zi0 * s0, zr1 * c1 + zi1 * s1);
                    *(u32x4*)(rowp + N2 + b) = pack8(zi0 * c0 - zr0 * s0, zi1 * c1 - zr1 * s1);
                    if (!lng) { const u32x4 z = (u32x4){0u, 0u, 0u, 0u}; *(u32x4*)(rowp + 64 + b) = z; *(u32x4*)(rowp + 96 + b) = z; } } }
            SCHED_FENCE(); }
    }
};
struct SchedF1 {
    int G, c; const char* A1; const char* YT;
    __device__ __forceinline__ bool next(int i, Unit& u) const {
        const int L = i * G + c; if (L >= 384) return false; int s, t;
        if (L < 256) { s = L >> 7; t = L & 127; } else { s = 2 + ((L - 256) >> 6); t = (L - 256) & 63; }
        u.A = A1; u.B = YT + yt_seq_off(s) * 2 + (size_t)t * 256 * 512; u.nt = 4; u.kind = s; u.c0 = t * 256; u.r0 = 0; u.dst = 0; return true;
    }
};
struct EpiF2 {
    static constexpr bool PERM = true, PRE = false, APERM = false;
    bf16_t* BR;
    __device__ __forceinline__ void operator()(const Acc& acc, const Unit& u, int wr, int wc, int fr, int fq) const {
        const int s = u.kind; const bool lng = s < 2; const float sc = lng ? 9.765625e-4f : 1.3810679320049757e-3f;
        if (wr != 0) return;
        const int st = seq_start(s);
#pragma unroll
        for (int m = 0; m < 4; ++m) { if (!lng && m >= 2) break; const int d = 16 * m + fr;
#pragma unroll
            for (int bj = 0; bj < 2; ++bj) { const int n0 = u.c0 + 128 * bj + 32 * wc + 8 * fq, c = n0 >> 9, col = n0 & 511;
                *(u32x4*)(BR + (size_t)(st + c + 128 * d) * D + 512 + col) = pack8(acc[0][bj][m][0] * sc, acc[0][bj][m][1] * sc); } }
    }
};
struct SchedF2 {
    int G, c; const char* A2L; const char* A2S; const char* ZT;
    __device__ __forceinline__ bool next(int i, Unit& u) const {
        const int L = i * G + c; if (L >= 1024) return false; const int s = L >> 8, t = L & 255;
        u.A = s < 2 ? A2L : A2S; u.B = ZT + (size_t)s * 65536 * 256 + (size_t)t * 256 * 256; u.nt = 2; u.kind = s; u.c0 = t * 256; u.r0 = 0; u.dst = 0; return true;
    }
};
__device__ __forceinline__ u32x4 ldg16_raw(const void* p) { u32x4 v; asm volatile("global_load_dwordx4 %0, %1, off" : "=v"(v) : "v"(p) : "memory"); return v; }
__device__ __forceinline__ u32x4 ldg16_so(const void* base, unsigned off) { u32x4 v; asm volatile("global_load_dwordx4 %0, %1, %2" : "=v"(v) : "v"(off), "s"(base) : "memory"); return v; }
__device__ __forceinline__ u32x4 ldg16_so_nt(const void* base, unsigned off) { u32x4 v; asm volatile("global_load_dwordx4 %0, %1, %2 nt" : "=v"(v) : "v"(off), "s"(base) : "memory"); return v; }
__device__ __forceinline__ u32x4 ldg16_raw256(const void* p) { u32x4 v; asm volatile("global_load_dwordx4 %0, %1, off offset:256" : "=v"(v) : "v"(p) : "memory"); return v; }
#define VM_WAIT(n) asm volatile("s_waitcnt vmcnt(" #n ")" ::: "memory")
#define VM_USE8(a, b, c, d, e, f, g, h) asm volatile("" : "+v"(a), "+v"(b), "+v"(c), "+v"(d), "+v"(e), "+v"(f), "+v"(g), "+v"(h))
struct EpiMerge {
    static constexpr bool PERM = true, PRE = false, APERM = false;
    bf16_t* MERGED; const bf16_t* GATES; const bf16_t* ZERO;
    __device__ __forceinline__ void ld(u32x4 (&gv)[2][2], u32x4 (&ov)[2][2], const Unit& u, int step, unsigned gvo, unsigned ovo) const {
        const int b = u.kind, ai = step >> 1;
        const bf16_t* gt = GATES + ((size_t)((u.r0 >> 8) * 32 + b * 8 + (u.c0 >> 8)) << 16);
        const bf16_t* ot = (b != 0) ? MERGED + (size_t)u.r0 * D + u.c0 : ZERO;
#pragma unroll
        for (int mm = 0; mm < 2; ++mm) { const int m = (step & 1) * 2 + mm;
            gv[mm][0] = ldg16_so_nt(gt + (((ai * 4 + m) * 2 + 0) * 8) * 512, gvo); gv[mm][1] = ldg16_so_nt(gt + (((ai * 4 + m) * 2 + 1) * 8) * 512, gvo);
            const bf16_t* orow = (b != 0) ? ot + (size_t)(ai * 128 + m * 16) * D : ot;
            ov[mm][0] = ldg16_so(orow, ovo); ov[mm][1] = ldg16_so(orow + 128, ovo); }
    }
    __device__ __forceinline__ void operator()(const Acc& acc, const Unit& u, int wr, int wc, int fr, int fq) const {
        const int ct0 = wc * 32 + 8 * fq;
        u32x4 gv[2][2][2], ov[2][2][2];
        const unsigned gvo = (unsigned)(((wr * 4 + wc) * 64 + fq * 16 + fr) * 16), ovo = (u.kind != 0) ? (unsigned)(((wr * 64 + fr) * D + ct0) * 2) : (unsigned)(ct0 * 2);
        ld(gv[0], ov[0], u, 0, gvo, ovo); ld(gv[1], ov[1], u, 1, gvo, ovo);
        SCHED_FENCE();
#pragma unroll
        for (int step = 0; step < 4; ++step) { const int ai = step >> 1, st = step & 1;
            if (step == 0 || step == 3) VM_WAIT(8); else if (step == 1) VM_WAIT(12); else VM_WAIT(16);
            VM_USE8(gv[st][0][0], gv[st][0][1], gv[st][1][0], gv[st][1][1], ov[st][0][0], ov[st][0][1], ov[st][1][0], ov[st][1][1]);
            SCHED_FENCE();
            u32x4 res[2][2];
#pragma unroll
            for (int mm = 0; mm < 2; ++mm) { const int m = st * 2 + mm;
#pragma unroll
                for (int bj = 0; bj < 2; ++bj) { const u32x4 g = gv[st][mm][bj], o = ov[st][mm][bj]; f32x4 v0 = acc[ai][bj][m][0], v1 = acc[ai][bj][m][1];
                    v0[0] = v0[0] * sig2_(bflo(g.x)) + bflo(o.x); v0[1] = v0[1] * sig2_(bfhi(g.x)) + bfhi(o.x); v0[2] = v0[2] * sig2_(bflo(g.y)) + bflo(o.y); v0[3] = v0[3] * sig2_(bfhi(g.y)) + bfhi(o.y);
                    v1[0] = v1[0] * sig2_(bflo(g.z)) + bflo(o.z); v1[1] = v1[1] * sig2_(bfhi(g.z)) + bfhi(o.z); v1[2] = v1[2] * sig2_(bflo(g.w)) + bflo(o.w); v1[3] = v1[3] * sig2_(bfhi(g.w)) + bfhi(o.w);
                    res[mm][bj] = pack8(v0, v1); } }
            SCHED_FENCE();
            if (step < 2) { ld(gv[st], ov[st], u, step + 2, gvo, ovo); SCHED_FENCE(); }
#pragma unroll
            for (int mm = 0; mm < 2; ++mm) { bf16_t* rowp = MERGED + (size_t)(u.r0 + ai * 128 + wr * 64 + (st * 2 + mm) * 16 + fr) * D + u.c0 + ct0;
#pragma unroll
                for (int bj = 0; bj < 2; ++bj) *(u32x4*)(rowp + bj * 128) = res[mm][bj]; }
            SCHED_FENCE(); }
    }
};
struct SchedMerge {
    int G, c; const char* BR; const char* WBRT;
    __device__ __forceinline__ bool next(int i, Unit& u) const {
        int pm, pn; if (!pg8::tile_order(i >> 2, G, c, 96, 8, pm, pn)) return false; const int b = i & 3;
        u.A = BR + (size_t)pm * 256 * 4096 + (size_t)b * 1024; u.B = WBRT + (size_t)b * (2048 * 1024) + (size_t)pn * 256 * 1024; u.nt = 8; u.kind = b; u.r0 = pm * 256; u.c0 = pn * 256; u.dst = 0; return true;
    }
};
template <int OFF> __device__ __forceinline__ f32x4 ldg16f_raw(const void* p) { f32x4 v; asm volatile("global_load_dwordx4 %0, %1, off offset:%2" : "=v"(v) : "v"(p), "n"(OFF) : "memory"); return v; }
#define VM_USE4(a, b, c, d) asm volatile("" : "+v"(a), "+v"(b), "+v"(c), "+v"(d))
struct EpiRes {
    static constexpr bool PERM = true, PRE = false, APERM = false;
    bf16_t* xb; const float* gate;
    __device__ __forceinline__ void ld(u32x4 (&xv)[2][2], const Unit& u, int step, int wr, int fr, int ct0) const {
#pragma unroll
        for (int mm = 0; mm < 2; ++mm) { const bf16_t* p = xb + (size_t)(u.r0 + (step >> 1) * 128 + wr * 64 + ((step & 1) * 2 + mm) * 16 + fr) * D + u.c0 + ct0;
            xv[mm][0] = ldg16_raw(p); xv[mm][1] = ldg16_raw256(p); }
    }
    __device__ __forceinline__ void operator()(const Acc& acc, const Unit& u, int wr, int wc, int fr, int fq) const {
        const int s = seq_of_row(u.r0); const int ct0 = wc * 32 + 8 * fq; const float* gv = gate + (size_t)s * 12288 + u.c0 + ct0;
        f32x4 g8[2][2]; u32x4 xv[2][2][2];
        g8[0][0] = ldg16f_raw<0>(gv); g8[0][1] = ldg16f_raw<16>(gv); g8[1][0] = ldg16f_raw<512>(gv); g8[1][1] = ldg16f_raw<528>(gv);
        ld(xv[0], u, 0, wr, fr, ct0); ld(xv[1], u, 1, wr, fr, ct0);
        SCHED_FENCE();
#pragma unroll
        for (int step = 0; step < 4; ++step) { const int ai = step >> 1, st = step & 1;
            if (step == 0) VM_WAIT(4); else if (step == 2) VM_WAIT(12); else VM_WAIT(8);
            if (step == 0) VM_USE4(g8[0][0], g8[0][1], g8[1][0], g8[1][1]);
            VM_USE4(xv[st][0][0], xv[st][0][1], xv[st][1][0], xv[st][1][1]);
            SCHED_FENCE();
            u32x4 res[2][2];
#pragma unroll
            for (int mm = 0; mm < 2; ++mm)
#pragma unroll
                for (int bj = 0; bj < 2; ++bj) { const u32x4 o = xv[st][mm][bj]; const int m = st * 2 + mm;
                    const f32x4 x0 = {bflo(o.x), bfhi(o.x), bflo(o.y), bfhi(o.y)}, x1 = {bflo(o.z), bfhi(o.z), bflo(o.w), bfhi(o.w)};
                    res[mm][bj] = pack8(x0 + g8[bj][0] * acc[ai][bj][m][0], x1 + g8[bj][1] * acc[ai][bj][m][1]); }
            SCHED_FENCE();
            if (step < 2) { ld(xv[st], u, step + 2, wr, fr, ct0); SCHED_FENCE(); }
#pragma unroll
            for (int mm = 0; mm < 2; ++mm) { bf16_t* rowp = xb + (size_t)(u.r0 + ai * 128 + wr * 64 + (st * 2 + mm) * 16 + fr) * D + u.c0 + ct0;
#pragma unroll
                for (int bj = 0; bj < 2; ++bj) *(u32x4*)(rowp + bj * 128) = res[mm][bj]; }
            SCHED_FENCE(); }
    }
};
struct SchedPlain {
    int G, c; const char* A; const char* B; int nN, nt; size_t rowb;
    __device__ __forceinline__ bool next(int i, Unit& u) const {
        int pm, pn; if (!pg8::tile_order(i, G, c, 96, nN, pm, pn)) return false;
        u.A = A + (size_t)pm * 256 * rowb; u.B = B + (size_t)pn * 256 * rowb; u.nt = nt; u.kind = 0; u.r0 = pm * 256; u.c0 = pn * 256; u.dst = 0; return true;
    }
};
struct EpiUpConv {
    static constexpr bool PERM = true, PRE = true, APERM = true;
    bf16_t* ACT; bf16_t* YB; const float* cw; const float* cb; LAS unsigned char* scr;
    __device__ __forceinline__ void pre(const Unit& u, int tid) const {
        const int kind = tid >> 7, ch = (u.c0 >> 1) + (tid & 127);
        const float* s0 = (kind < 3) ? cw + (size_t)kind * NUP + ch : cb + ch;
        LAS unsigned char* d = scr + u.dst + __builtin_amdgcn_readfirstlane(tid >> 6) * 256;
        __builtin_amdgcn_global_load_lds((const unsigned*)s0, (LAS unsigned*)d, 4, 0, 0);
        __builtin_amdgcn_global_load_lds((const unsigned*)(s0 + DFF), (LAS unsigned*)(d + 2048), 4, 0, 0);
    }
    __device__ __forceinline__ void operator()(const Acc& acc, const Unit& u, int wr, int wc, int fr, int fq) const {
        const int chl0 = 32 * wc + 8 * fq, chan0 = (u.c0 >> 1) + chl0;
        const LAS unsigned char* wl = scr + u.dst;
#pragma unroll
        for (int ai = 0; ai < 2; ++ai) { const int row0 = u.r0 + ai * 128 + wr * 64 + 4 * fr; unsigned w0[4][2];
#pragma unroll
            for (int n = 0; n < 2; ++n) { unsigned wv[4];
#pragma unroll
                for (int ep = 0; ep < 2; ++ep) { const int e0 = 2 * ep; const LAS unsigned char* wp = wl + (chl0 + 4 * n + e0) * 4;
                    const f32x2 a0p = *(const LAS f32x2*)(wp), a1p = *(const LAS f32x2*)(wp + 512), a2p = *(const LAS f32x2*)(wp + 1024), abp = *(const LAS f32x2*)(wp + 1536);
                    const f32x2 b0p = *(const LAS f32x2*)(wp + 2048), b1p = *(const LAS f32x2*)(wp + 2560), b2p = *(const LAS f32x2*)(wp + 3072), bbp = *(const LAS f32x2*)(wp + 3584);
                    f32x2 y[2][4];
#pragma unroll
                    for (int bj = 0; bj < 2; ++bj)
#pragma unroll
                        for (int m = 0; m < 4; ++m) y[bj][m] = (f32x2){acc[ai][bj][m][n][e0], acc[ai][bj][m][n][e0 + 1]};
                    const f32x2 pa0 = {dpp_ror1(y[0][3].x), dpp_ror1(y[0][3].y)}, na3 = {dpp_ror15(y[0][0].x), dpp_ror15(y[0][0].y)};
                    const f32x2 pb0 = {dpp_ror1(y[1][3].x), dpp_ror1(y[1][3].y)}, nb3 = {dpp_ror15(y[1][0].x), dpp_ror15(y[1][0].y)};
                    f32x2 ua[4], ub[4], ex[4];
#pragma unroll
                    for (int m = 0; m < 4; ++m) {
                        const f32x2 pa = m > 0 ? y[0][m > 0 ? m - 1 : 0] : pa0, na = m < 3 ? y[0][m < 3 ? m + 1 : 3] : na3;
                        const f32x2 pb = m > 0 ? y[1][m > 0 ? m - 1 : 0] : pb0, nb = m < 3 ? y[1][m < 3 ? m + 1 : 3] : nb3;
                        ua[m] = a0p * pa + (a1p * y[0][m] + (a2p * na + abp)); ub[m] = b0p * pb + (b1p * y[1][m] + (b2p * nb + bbp));
                        const f32x2 q = ua[m] * (ua[m] * ua[m] * 0.10294324f + 2.3022082f);
                        ex[m].x = __builtin_amdgcn_exp2f(q.x); ex[m].y = __builtin_amdgcn_exp2f(q.y); }
                    SCHED_FENCE();
#pragma unroll
                    for (int m = 0; m < 4; ++m) { ex[m] = ex[m] + 1.0f; ex[m].x = fast_rcp(ex[m].x); ex[m].y = fast_rcp(ex[m].y); }
                    SCHED_FENCE();
#pragma unroll
                    for (int m = 0; m < 4; ++m) { const f32x2 o = (ua[m] - ua[m] * ex[m]) * ub[m];
                        const unsigned wn = cvt_pk_bf16(o.x, o.y);
                        if (ep == 0) wv[m] = wn;
                        else if (n == 0) { w0[m][0] = wv[m]; w0[m][1] = wn; }
                        else { u32x4 w; w.x = w0[m][0]; w.y = w0[m][1]; w.z = wv[m]; w.w = wn;
                            __builtin_nontemporal_store(w, (u32x4*)(ACT + (size_t)(row0 + m) * DFF + chan0)); } } } }
            SCHED_FENCE(); }
        if (fr == 0 || fr == 15) {
#pragma unroll
            for (int ai = 0; ai < 2; ++ai) { const int blk = (u.r0 + ai * 128 + wr * 64) >> 6;
#pragma unroll
                for (int j = 0; j < 2; ++j) { bf16_t* yp = YB + ((size_t)blk * 4 + (fr == 0 ? j : 2 + j)) * NUP + chan0;
#pragma unroll
                    for (int bj = 0; bj < 2; ++bj) { const f32x4 v0 = (fr == 0) ? acc[ai][bj][j][0] : acc[ai][bj][2 + j][0], v1 = (fr == 0) ? acc[ai][bj][j][1] : acc[ai][bj][2 + j][1];
                        *(u32x4*)(yp + bj * DFF) = pack8(v0, v1); } } } }
    }
};

struct Args { const float* in[23]; float* out; unsigned char* ws; int ph_lo, ph_hi; };
struct Frame {
    LAS unsigned char* lds; int tid, lane, wave, G, gw, NGW, bid;
    float* out; unsigned char* ws;
};
#define LDS_WAIT() asm volatile("s_waitcnt lgkmcnt(0)" ::: "memory")

__device__ __forceinline__ void transpose_item(const float* W, int K, int N, bf16_t* WT, int drow, int k0, int n0, LAS float* scr, int lane) {
    (void)scr; const int kq = lane >> 3, n4 = lane & 7;
    f32x4 tv[8];
#pragma unroll
    for (int i = 0; i < 8; ++i) tv[i] = *(const f32x4*)(W + (size_t)(k0 + 8 * kq + i) * N + n0 + 4 * n4);
#pragma unroll
    for (int e = 0; e < 4; ++e) { u32x4 o; o.x = cvt_pk_bf16(tv[0][e], tv[1][e]); o.y = cvt_pk_bf16(tv[2][e], tv[3][e]); o.z = cvt_pk_bf16(tv[4][e], tv[5][e]); o.w = cvt_pk_bf16(tv[6][e], tv[7][e]);
        *(u32x4*)(WT + (size_t)(drow + 4 * n4 + e) * K + k0 + 8 * kq) = o; }
}
__device__ __forceinline__ int map_in(int n0) {
    if (n0 < 1024) return n0;
    if (n0 < 2048) { const int off = n0 - 1024, which = off >> 9, hh = (off & 511) >> 7, d = off & 127, half = d >> 6, jd = d & 63; return 1024 + which * 512 + (hh >> 1) * 256 + half * 128 + (hh & 1) * 64 + jd; }
    if (n0 < 2560) return 3584 + (n0 - 2048);
    if (n0 < 3072) return 2048 + (n0 - 2560);
    if (n0 < 3584) return 2560 + (n0 - 3072);
    if (n0 < 4096) return 3072 + (n0 - 3584);
    return n0;
}
constexpr int CV_IN = (D / 64) * (INW / 32), CV_G = (D / 64) * (NGATE / 32), CV_BR = (512 / 64) * (D / 32), CV_OUT = (D / 64) * (D / 32), CV_UP = (D / 64) * (NUP / 32), CV_DN = (DFF / 64) * (D / 32);
constexpr int CV_A = CV_IN + CV_G + 3 * CV_BR + CV_OUT, CV_N = CV_A + CV_UP + CV_DN;
constexpr int CV_QG1 = 5120, CV_QUP = 10240;
__device__ __forceinline__ void convert_span(Frame& F, int l, const float* w_in0, const float* w_gate0, const float* w_branch0, const float* w_out0, const float* w_up0, const float* w_down0, int lo1, int len1, int lo2, int len2, int w0, int nw) {
    const float* w_in = w_in0 + (size_t)l * D * INW; const float* w_gate = w_gate0 + (size_t)l * D * NGATE; const float* w_branch = w_branch0 + (size_t)l * 4 * 512 * D;
    const float* w_out = w_out0 + (size_t)l * D * D; const float* w_up = w_up0 + (size_t)l * D * NUP; const float* w_down = w_down0 + (size_t)l * DFF * D;
    bf16_t* W1T = (bf16_t*)(F.ws + WS_W1T); bf16_t* WBRT = (bf16_t*)(F.ws + WS_WBRT); bf16_t* WOUTT = (bf16_t*)(F.ws + WS_WOUTT); bf16_t* WUPT = (bf16_t*)(F.ws + WS_WUPT); bf16_t* WDNT = (bf16_t*)(F.ws + WS_WDNT);
    LAS float* scr = nullptr;
    for (int v = w0; v < len1 + len2; v += nw) {
        int r = v < len1 ? lo1 + v : lo2 + (v - len1);
        if (r < CV_IN) { const int nb = INW / 32, kb = r / nb, n0 = (r % nb) * 32; transpose_item(w_in, D, INW, W1T, map_in(n0), kb * 64, n0, scr, F.lane); continue; } r -= CV_IN;
        if (r < CV_G) { const int nb = NGATE / 32, kb = r / nb, n0 = (r % nb) * 32; transpose_item(w_gate, D, NGATE, W1T, 4608 + n0, kb * 64, n0, scr, F.lane); continue; } r -= CV_G;
        if (r < 3 * CV_BR) { const int b = 1 + r / CV_BR, rr = r % CV_BR, nb = D / 32, kb = rr / nb, n0 = (rr % nb) * 32; transpose_item(w_branch + (size_t)b * 512 * D, 512, D, WBRT + (size_t)b * D * 512, n0, kb * 64, n0, scr, F.lane); continue; } r -= 3 * CV_BR;
        if (r < CV_OUT) { const int nb = D / 32, kb = r / nb, n0 = (r % nb) * 32; transpose_item(w_out, D, D, WOUTT, n0, kb * 64, n0, scr, F.lane); continue; } r -= CV_OUT;
        if (r < CV_UP) { const int nb = NUP / 32, kb = r / nb, n0 = (r % nb) * 32; transpose_item(w_up, D, NUP, WUPT, (n0 < DFF ? (n0 >> 7) * 256 + (n0 & 127) : ((n0 - DFF) >> 7) * 256 + 128 + ((n0 - DFF) & 127)), kb * 64, n0, scr, F.lane); continue; } r -= CV_UP;
        { const int nb = D / 32, kb = r / nb, n0 = (r % nb) * 32; transpose_item(w_down, DFF, D, WDNT, n0, kb * 64, n0, scr, F.lane); }
    }
}
__device__ __forceinline__ void convert_tail(Frame& F, int l, const float* w_in0, const float* w_gate0, const float* w_branch0, const float* w_out0, const float* w_up0, const float* w_down0, int nwg, int lo, int len) {
    const int rem = nwg % F.G; if (rem != 0 && F.bid < rem) return;
    const int nidle = rem ? F.G - rem : F.G, rank = rem ? F.bid - rem : F.bid;
    convert_span(F, l, w_in0, w_gate0, w_branch0, w_out0, w_up0, w_down0, lo, len, 0, 0, rank * NWAVES + F.wave, nidle * NWAVES);
}
__device__ __forceinline__ void convert_weights(Frame& F, int l, const float* w_in0, const float* w_gate0, const float* w_branch0, const float* w_out0, const float* w_up0, const float* w_down0, const float* pool_w0, const float* pool_scale0, bool skip_up) {
    const int q = skip_up ? CV_QUP : 0;
    convert_span(F, l, w_in0, w_gate0, w_branch0, w_out0, w_up0, w_down0, q, CV_A - q, CV_A + CV_QG1, CV_N - CV_A - CV_QG1, F.gw, F.NGW);
    const float* w_branch = w_branch0 + (size_t)l * 4 * 512 * D; bf16_t* WBRT = (bf16_t*)(F.ws + WS_WBRT);
    const float* pw = pool_w0 + (size_t)l * 4 * 128 * 128; const float* ps = pool_scale0 + (size_t)l * 512;
    for (int item = F.bid; item < 256; item += F.G) {
        const int g = item >> 6, ns = (item >> 3) & 7, c0 = (item & 7) * 16 + 2 * F.wave, n0 = ns * 256 + 4 * F.lane;
        float cf[2][2];
#pragma unroll
        for (int j = 0; j < 2; ++j)
#pragma unroll
            for (int h = 0; h < 2; ++h) cf[j][h] = pw[((size_t)g * 128 + c0 + j) * 128 + 64 * h + F.lane] * ps[g * 128 + 64 * h + F.lane];
        const float* wb = w_branch + (size_t)(g * 128) * D + n0;
        f32x4 a0 = (f32x4){0.f, 0.f, 0.f, 0.f}, a1 = a0;
#pragma unroll
        for (int h = 0; h < 2; ++h)
#pragma unroll 16
            for (int el = 0; el < 64; ++el) { const f32x4 w = *(const f32x4*)(wb + (size_t)(64 * h + el) * D);
                const float k0 = __builtin_bit_cast(float, __builtin_amdgcn_readlane(__builtin_bit_cast(int, cf[0][h]), el)), k1 = __builtin_bit_cast(float, __builtin_amdgcn_readlane(__builtin_bit_cast(int, cf[1][h]), el));
                a0 += w * k0; a1 += w * k1; }
        const int k = g * 128 + c0;
#pragma unroll
        for (int j = 0; j < 4; ++j) *(unsigned*)(WBRT + (size_t)(n0 + j) * 512 + k) = cvt_pk_bf16(a0[j], a1[j]);
    }
}
__device__ __forceinline__ void prologue_tables(Frame& F) {
    float* rc = (float*)(F.ws + WS_ROPEC); float* rs = (float*)(F.ws + WS_ROPES);
    const int gt = F.bid * NTHREADS + F.tid, NGT = F.G * NTHREADS;
    for (int it = gt; it < 8192 * 64; it += NGT) { const int pos = it >> 6, j = it & 63;
        const float inv = __builtin_amdgcn_exp2f(-(float)j * (13.287712379549449f / 64.0f)); const float ang = (float)pos * inv;
        const double rev = (double)ang * 0.15915494309189535; const float fr = (float)(rev - floor(rev));
        const float cv = __builtin_amdgcn_cosf(fr), sv = __builtin_amdgcn_sinf(fr);
        rc[it] = cv; rs[it] = sv; }
    bf16_t* d2 = (bf16_t*)(F.ws + WS_D2);
    for (int it = gt; it < 256 * 128; it += NGT) { const int r = it >> 7, c = it & 127, s = r >> 7, kc = r & 127; const float fr = (float)((c * kc) & 127) * (1.0f / 128.0f);
        const float v = s ? __builtin_amdgcn_sinf(fr) : __builtin_amdgcn_cosf(fr); d2[it] = (bf16_t)(cvt_pk_bf16(v, 0.f) & 0xffffu); }
    bf16_t* a1 = (bf16_t*)(F.ws + WS_A1);
    for (int it = gt; it < 256 * 256; it += NGT) { const int r = it >> 8, k = it & 255, pp = r >> 7, c = r & 127, p = k >> 7, a = k & 127; const float fr = (float)((a * c) & 127) * (1.0f / 128.0f);
        const float cv = __builtin_amdgcn_cosf(fr), sv = __builtin_amdgcn_sinf(fr); const float v = (pp == 0) ? (p == 0 ? cv : -sv) : (p == 0 ? -sv : -cv); a1[it] = (bf16_t)(cvt_pk_bf16(v, 0.f) & 0xffffu); }
    bf16_t* a2l = (bf16_t*)(F.ws + WS_A2L); bf16_t* a2s = (bf16_t*)(F.ws + WS_A2S);
    for (int it = gt; it < 256 * 128; it += NGT) { const int d = it >> 7, k = it & 127;
        { const int p = k >> 6, b = k & 63; const float fr = (float)((b * d) & 63) * (1.0f / 64.0f); const float v = d < 64 ? (p ? __builtin_amdgcn_sinf(fr) : __builtin_amdgcn_cosf(fr)) : 0.f; a2l[it] = (bf16_t)(cvt_pk_bf16(v, 0.f) & 0xffffu); }
        { const int p = (k >> 5) & 1, b = k & 31; const float fr = (float)((b * d) & 31) * (1.0f / 32.0f); const float v = (d < 32 && k < 64) ? (p ? __builtin_amdgcn_sinf(fr) : __builtin_amdgcn_cosf(fr)) : 0.f; a2s[it] = (bf16_t)(cvt_pk_bf16(v, 0.f) & 0xffffu); } }
    float* twl = (float*)(F.ws + WS_TWL); float* tws = (float*)(F.ws + WS_TWS);
    for (int it = gt; it < 128 * 64; it += NGT) { const int c = it >> 6, b = it & 63; const float fr = (float)(b * c) * (1.0f / 8192.0f); twl[it] = __builtin_amdgcn_cosf(fr); twl[128 * 64 + it] = __builtin_amdgcn_sinf(fr); }
    for (int it = gt; it < 128 * 32; it += NGT) { const int c = it >> 5, b = it & 31; const float fr = (float)(b * c) * (1.0f / 4096.0f); tws[it] = __builtin_amdgcn_cosf(fr); tws[128 * 32 + it] = __builtin_amdgcn_sinf(fr); }
}
__device__ __forceinline__ void prologue_mod_partial(Frame& F, const float* c_prompt, const float* c_sample, const float* w_ada) {
    LAS float* sc = (LAS float*)F.lds;
    for (int i = F.tid; i < 4 * D; i += NTHREADS) { const int s = i >> 11, k = i & (D - 1); const float v = (s < 2 ? c_prompt : c_sample)[(s & 1) * D + k]; sc[i] = v * sigmoidf_(v); }
    __syncthreads();
    float* modp = (float*)(F.ws + WS_MODP);
    const int kq = F.tid >> 7, n4 = (F.tid & 127) * 4;
    for (int it = F.bid; it < DEPTH * 24 * 8; it += F.G) { const int l = it / 192, nb = (it % 192) >> 3, kp = it & 7; const int n = nb * 512 + n4, kbase = kp * 256 + kq * 64;
        const float* w = w_ada + ((size_t)l * D + kbase) * 12288 + n; f32x4 a0 = (f32x4){0.f, 0.f, 0.f, 0.f}, a1 = a0, a2 = a0, a3 = a0;
#pragma unroll 16
        for (int k = 0; k < 64; ++k) { const f32x4 wv = *(const f32x4*)(w + (size_t)k * 12288); const int kk = kbase + k; a0 += wv * sc[kk]; a1 += wv * sc[D + kk]; a2 += wv * sc[2 * D + kk]; a3 += wv * sc[3 * D + kk]; }
        float* o = modp + ((size_t)((kp * 4 + kq) * DEPTH + l) * 4) * 12288 + n; *(f32x4*)o = a0; *(f32x4*)(o + 12288) = a1; *(f32x4*)(o + 2 * 12288) = a2; *(f32x4*)(o + 3 * 12288) = a3; }
    __syncthreads();
}
__device__ __forceinline__ void prologue_mod_reduce(Frame& F, const float* b_ada) {
    const float* modp = (const float*)(F.ws + WS_MODP); float* mod = (float*)(F.ws + WS_MOD);
    for (int it = F.bid * NTHREADS + F.tid; it < DEPTH * 4 * 12288; it += F.G * NTHREADS) { const int n = it % 12288, l = it / (4 * 12288);
        float a = b_ada[(size_t)l * 12288 + n];
#pragma unroll
        for (int kp = 0; kp < 32; ++kp) a += modp[(size_t)kp * DEPTH * 4 * 12288 + it];
        mod[it] = a; }
}
__device__ __forceinline__ void unpack_row(const u32x4 (&w)[4], f32x4 (&v)[8]) {
#pragma unroll
    for (int j = 0; j < 4; ++j) { v[2 * j] = (f32x4){bflo(w[j].x), bfhi(w[j].x), bflo(w[j].y), bfhi(w[j].y)}; v[2 * j + 1] = (f32x4){bflo(w[j].z), bfhi(w[j].z), bflo(w[j].w), bfhi(w[j].w)}; }
}
__device__ __forceinline__ float sumsq8(const f32x4 (&v)[8]) { float s = 0.f;
#pragma unroll
    for (int j = 0; j < 8; ++j) s += (v[j].x * v[j].x + v[j].y * v[j].y) + (v[j].z * v[j].z + v[j].w * v[j].w);
    return s; }
template <bool SEED>
__device__ __forceinline__ void norm_phase(Frame& F, const float* xp, const float* xs, const float* g, const float* mod_l, int shift_off, int scale_off) {
    bf16_t* H = (bf16_t*)(F.ws + WS_H); bf16_t* XB = (bf16_t*)(F.ws + WS_XB);
    constexpr int RB = SEED ? 2 : 4;
    const int per = 4 * ((MTOK / 4 + F.NGW - 1) / F.NGW), m0 = F.gw * per;
    int cs = -1; f32x4 gs[8], hv[8];
#pragma unroll 1
    for (int i = 0; i < per; i += RB) {
        const int m = m0 + i; if (m >= MTOK) break; const int s = seq_of_row(m);
        if (s != cs) { cs = s; const float* sh = mod_l + (size_t)s * 12288 + shift_off; const float* scl = mod_l + (size_t)s * 12288 + scale_off;
            f32x4 gg[8], sv[8];
#pragma unroll
            for (int j = 0; j < 8; ++j) { const int c = SEED ? 4 * F.lane + 256 * j : 8 * F.lane + 512 * (j >> 1) + 4 * (j & 1); gg[j] = *(const f32x4*)(g + c); sv[j] = *(const f32x4*)(scl + c); hv[j] = *(const f32x4*)(sh + c); }
            SCHED_FENCE();
#pragma unroll
            for (int j = 0; j < 8; ++j) gs[j] = gg[j] * (sv[j] + 1.0f); }
        if (SEED) { f32x4 v0[8], v1[8];
            const float* x0 = (m < 16384 ? xp : xs) + (size_t)m * D; const float* x1 = x0 + D;
#pragma unroll
            for (int j = 0; j < 8; ++j) { v0[j] = *(const f32x4*)(x0 + 4 * F.lane + 256 * j); v1[j] = *(const f32x4*)(x1 + 4 * F.lane + 256 * j); }
#pragma unroll
            for (int j = 0; j < 8; ++j) { const int c = 4 * F.lane + 256 * j; u32x2 w0, w1; w0.x = cvt_pk_bf16(v0[j].x, v0[j].y); w0.y = cvt_pk_bf16(v0[j].z, v0[j].w); w1.x = cvt_pk_bf16(v1[j].x, v1[j].y); w1.y = cvt_pk_bf16(v1[j].z, v1[j].w);
                *(u32x2*)(XB + (size_t)m * D + c) = w0; *(u32x2*)(XB + (size_t)(m + 1) * D + c) = w1; }
            const float r0 = __builtin_amdgcn_rsqf(wave_sum(sumsq8(v0)) * (1.0f / D) + EPS), r1 = __builtin_amdgcn_rsqf(wave_sum(sumsq8(v1)) * (1.0f / D) + EPS);
#pragma unroll
            for (int j = 0; j < 8; ++j) { const int c = 4 * F.lane + 256 * j; const f32x4 y0 = v0[j] * r0 * gs[j] + hv[j], y1 = v1[j] * r1 * gs[j] + hv[j];
                u32x2 w0, w1; w0.x = cvt_pk_bf16(y0.x, y0.y); w0.y = cvt_pk_bf16(y0.z, y0.w); w1.x = cvt_pk_bf16(y1.x, y1.y); w1.y = cvt_pk_bf16(y1.z, y1.w);
                *(u32x2*)(H + (size_t)m * D + c) = w0; *(u32x2*)(H + (size_t)(m + 1) * D + c) = w1; } }
        else { const bf16_t* b0 = XB + (size_t)m * D + 8 * F.lane; u32x4 w[4][4];
#pragma unroll
            for (int rr = 0; rr < 4; ++rr)
#pragma unroll
                for (int j = 0; j < 4; ++j) w[rr][j] = *(const u32x4*)(b0 + (size_t)rr * D + 512 * j);
            SCHED_FENCE();
#pragma unroll
            for (int rr = 0; rr < 4; ++rr) { f32x4 v[8]; unpack_row(w[rr], v);
                const float r = __builtin_amdgcn_rsqf(wave_sum(sumsq8(v)) * (1.0f / D) + EPS);
#pragma unroll
                for (int j = 0; j < 4; ++j) *(u32x4*)(H + (size_t)(m + rr) * D + 8 * F.lane + 512 * j) = pack8(v[2 * j] * r * gs[2 * j] + hv[2 * j], v[2 * j + 1] * r * gs[2 * j + 1] + hv[2 * j + 1]); } }
    }
}
__device__ __forceinline__ void final_norm_phase(Frame& F, const float* g_final) {
    const bf16_t* XB = (const bf16_t*)(F.ws + WS_XB);
    const int per = 4 * ((MTOK / 4 + F.NGW - 1) / F.NGW), m0 = F.gw * per;
    f32x4 gg[8];
#pragma unroll
    for (int j = 0; j < 8; ++j) gg[j] = *(const f32x4*)(g_final + 8 * F.lane + 512 * (j >> 1) + 4 * (j & 1));
#pragma unroll 1
    for (int i = 0; i < per; i += 4) { const int m = m0 + i; if (m >= MTOK) break;
        const bf16_t* b0 = XB + (size_t)m * D + 8 * F.lane; u32x4 w[4][4];
#pragma unroll
        for (int rr = 0; rr < 4; ++rr)
#pragma unroll
            for (int j = 0; j < 4; ++j) w[rr][j] = *(const u32x4*)(b0 + (size_t)rr * D + 512 * j);
        SCHED_FENCE();
#pragma unroll
        for (int rr = 0; rr < 4; ++rr) { f32x4 v[8]; unpack_row(w[rr], v);
            const float r = __builtin_amdgcn_rsqf(wave_sum(sumsq8(v)) * (1.0f / D) + EPS);
            float* xr = F.out + (size_t)(m + rr) * D + 8 * F.lane;
#pragma unroll
            for (int j = 0; j < 8; ++j) *(f32x4*)(xr + 512 * (j >> 1) + 4 * (j & 1)) = v[j] * r * gg[j]; } }
}
__device__ __forceinline__ void pool_phase(Frame& F) {
    const bf16_t* P = (const bf16_t*)(F.ws + WS_P); bf16_t* BR = (bf16_t*)(F.ws + WS_BR);
    for (int it = F.bid * NTHREADS + F.tid; it < MTOK * 64; it += F.G * NTHREADS) {
        const int m = it >> 6, c = it & 63, s = seq_of_row(m), st = seq_start(s), T = seq_len(s), pos = m - st, half = 1 << (c >> 4);
        const int lo = max(pos - half, 0), hi = min(pos + half, T);
        u32x4 w[16]; const u32x4 z = (u32x4){0u, 0u, 0u, 0u};
#pragma unroll
        for (int k = 0; k < 16; ++k) { const int t = lo + k; w[k] = (t < hi) ? *(const u32x4*)(P + (size_t)(st + t) * INW + 8 * c) : z; }
        const u32x4 ws = *(const u32x4*)(P + (size_t)m * INW + 8 * c);
        float a[8];
#pragma unroll
        for (int e = 0; e < 8; ++e) a[e] = 0.f;
#pragma unroll
        for (int k = 0; k < 16; ++k) { a[0] += bflo(w[k].x); a[1] += bfhi(w[k].x); a[2] += bflo(w[k].y); a[3] += bfhi(w[k].y); a[4] += bflo(w[k].z); a[5] += bfhi(w[k].z); a[6] += bflo(w[k].w); a[7] += bfhi(w[k].w); }
        const float ic = fast_rcp((float)(hi - lo));
        u32x4 o; o.x = cvt_pk_bf16(a[0] * ic - bflo(ws.x), a[1] * ic - bfhi(ws.x)); o.y = cvt_pk_bf16(a[2] * ic - bflo(ws.y), a[3] * ic - bfhi(ws.y));
        o.z = cvt_pk_bf16(a[4] * ic - bflo(ws.z), a[5] * ic - bfhi(ws.z)); o.w = cvt_pk_bf16(a[6] * ic - bflo(ws.w), a[7] * ic - bfhi(ws.w));
        *(u32x4*)(BR + (size_t)m * D + 8 * c) = o;
    }
}
__device__ __forceinline__ void conv_fix_phase(Frame& F, int l, const float* conv_w, const float* conv_b) {
    const bf16_t* YB = (const bf16_t*)(F.ws + WS_Y); bf16_t* ACT = (bf16_t*)(F.ws + WS_ACT);
    const float* cw = conv_w + (size_t)l * 3 * NUP; const float* cb = conv_b + (size_t)l * NUP;
    for (int it = F.bid * NTHREADS + F.tid; it < 384 * 2 * 704; it += F.G * NTHREADS) {
        const int c = it % 704, be = it / 704, edge = be & 1, blk = be >> 1, row = blk * 64 + (edge ? 63 : 0);
        const int s = seq_of_row(row), pos = row - seq_start(s); const bool hasp = pos > 0, hasn = pos < seq_len(s) - 1;
        const u32x4 z = (u32x4){0u, 0u, 0u, 0u};
        const bf16_t* rp = edge ? YB + ((size_t)blk * 4 + 2) * NUP : YB + ((size_t)(blk - 1) * 4 + 3) * NUP;
        const bf16_t* rc = YB + ((size_t)blk * 4 + (edge ? 3 : 0)) * NUP;
        const bf16_t* rn = edge ? YB + ((size_t)(blk + 1) * 4 + 0) * NUP : YB + ((size_t)blk * 4 + 1) * NUP;
        const bool okp = edge ? true : hasp, okn = edge ? hasn : true;
        float o[8];
#pragma unroll
        for (int hb = 0; hb < 2; ++hb) { const int col = hb * DFF + 8 * c; float uv[8];
            const u32x4 yp = okp ? *(const u32x4*)(rp + col) : z, yc = *(const u32x4*)(rc + col), yn = okn ? *(const u32x4*)(rn + col) : z;
            const f32x4 w0a = *(const f32x4*)(cw + col), w0b = *(const f32x4*)(cw + col + 4), w1a = *(const f32x4*)(cw + NUP + col), w1b = *(const f32x4*)(cw + NUP + col + 4), w2a = *(const f32x4*)(cw + 2 * NUP + col), w2b = *(const f32x4*)(cw + 2 * NUP + col + 4);
            const f32x4 ba = *(const f32x4*)(cb + col), bb = *(const f32x4*)(cb + col + 4);
            uv[0] = bflo(yp.x) * w0a[0] + bflo(yc.x) * w1a[0] + bflo(yn.x) * w2a[0] + ba[0]; uv[1] = bfhi(yp.x) * w0a[1] + bfhi(yc.x) * w1a[1] + bfhi(yn.x) * w2a[1] + ba[1];
            uv[2] = bflo(yp.y) * w0a[2] + bflo(yc.y) * w1a[2] + bflo(yn.y) * w2a[2] + ba[2]; uv[3] = bfhi(yp.y) * w0a[3] + bfhi(yc.y) * w1a[3] + bfhi(yn.y) * w2a[3] + ba[3];
            uv[4] = bflo(yp.z) * w0b[0] + bflo(yc.z) * w1b[0] + bflo(yn.z) * w2b[0] + bb[0]; uv[5] = bfhi(yp.z) * w0b[1] + bfhi(yc.z) * w1b[1] + bfhi(yn.z) * w2b[1] + bb[1];
            uv[6] = bflo(yp.w) * w0b[2] + bflo(yc.w) * w1b[2] + bflo(yn.w) * w2b[2] + bb[2]; uv[7] = bfhi(yp.w) * w0b[3] + bfhi(yc.w) * w1b[3] + bfhi(yn.w) * w2b[3] + bb[3];
#pragma unroll
            for (int e = 0; e < 8; ++e) o[e] = hb ? o[e] * uv[e] : gelu_tanh(uv[e]); }
        u32x4 w; w.x = cvt_pk_bf16(o[0], o[1]); w.y = cvt_pk_bf16(o[2], o[3]); w.z = cvt_pk_bf16(o[4], o[5]); w.w = cvt_pk_bf16(o[6], o[7]);
        *(u32x4*)(ACT + (size_t)row * DFF + 8 * c) = w;
    }
}
constexpr int NA_SLOTS = 9;
constexpr int NAK_PITCH = 144, NAK_ROW = 64 * NAK_PITCH, NAK_BYTES = NA_SLOTS * NAK_ROW;
constexpr int NAV_PITCH = NA_SLOTS * 128 + 16, NAV_BYTES = 64 * NAV_PITCH;
constexpr int NA_RPB_OFF = NAK_BYTES + NAV_BYTES;
static_assert(NA_RPB_OFF + 465 * 4 <= LDS_MISC, "neighbourhood ring does not fit");
__device__ __forceinline__ void na_item(int I, int& s, int& h, int& r) { if (I < 2048) { s = I >> 10; h = (I >> 7) & 7; r = I & 127; } else { const int J = I - 2048; s = 2 + (J >> 9); h = (J >> 6) & 7; r = J & 63; } }
__device__ __forceinline__ void na_phase(Frame& F, int l, const float* rpb0, int part) {
    const bf16_t* P = (const bf16_t*)(F.ws + WS_P); const bf16_t* PT = (const bf16_t*)(F.ws + WS_PT); bf16_t* BR = (bf16_t*)(F.ws + WS_BR);
    const float* rpb = rpb0 + (size_t)l * 8 * 465;
    const int lane = F.lane, x = lane & 15, g = lane >> 4, qb = F.wave & 3, it = F.wave >> 2, tid = F.tid;
    LAS unsigned char* kr_ = F.lds; LAS unsigned char* vr_ = F.lds + NAK_BYTES; LAS float* rl = (LAS float*)(F.lds + NA_RPB_OFF);
    int I0, I1;
    if (F.G == 256) { const int c_ = F.bid; const int st0 = part == 0 ? (c_ < 128 ? 4 * c_ : 512 + 6 * (c_ - 128)) : 1280 + 2 * (c_ - 128), ns = part == 0 ? (c_ < 128 ? 4 : 6) : (c_ < 128 ? 0 : 2); I0 = 2 * st0; I1 = I0 + 2 * ns; }
    else { const int per = 2 * ((1536 + F.G - 1) / F.G); I0 = part == 0 ? F.bid * per : 0; I1 = part == 0 ? min(I0 + per, 3072) : 0; }
    const int w0 = qb == 0 ? 0 : (qb == 1 ? 8 : (qb == 2 ? 24 : 32));
    int cs = -1, ch = -1, hi = 0;
    const int ckey = tid >> 3, cch = tid & 7;
    u32x4 pk[2], pv[2]; int prow = -1;
    pk[0] = pk[1] = pv[0] = pv[1] = (u32x4){0u, 0u, 0u, 0u};
    for (int I = I0; I < I1; I += 2) {
        int s, h, r; na_item(I, s, h, r); const int rows = seq_len(s) >> 6, st = seq_start(s);
        const int rsA = min(max(r - 4, 0), rows - 8), rsB = min(max(r - 3, 0), rows - 8);
        const bool fresh = (s != cs) || (h != ch) || (rsA + 9 < hi) || (rsA > hi);
        const int lo_new = fresh ? rsA : hi, hi_new = rsB + 8;
        __syncthreads();
        if (fresh && (s != cs || h != ch)) { for (int i = tid; i < 465; i += NTHREADS) rl[i] = rpb[(size_t)h * 465 + i]; }
        for (int kr = lo_new; kr < hi_new; ++kr) { const int slot = kr % NA_SLOTS, tok0 = st + kr * 64; u32x4 kv, vv;
            if (!fresh && kr == prow) { kv = pk[0]; vv = pv[0]; }
            else if (!fresh && kr == prow + 1 && prow >= 0) { kv = pk[1]; vv = pv[1]; }
            else { kv = *(const u32x4*)(P + (size_t)(tok0 + ckey) * INW + 3584 + h * 64 + 8 * cch); vv = *(const u32x4*)(PT + (size_t)(1024 + h * 64 + ckey) * MTOK + tok0 + 8 * cch); }
            *(LAS u32x4*)(kr_ + slot * NAK_ROW + ckey * NAK_PITCH + 16 * cch) = kv;
            *(LAS u32x4*)(vr_ + ckey * NAV_PITCH + (slot * 64 + 8 * cch) * 2) = vv; }
        cs = s; ch = h; hi = hi_new; prow = -1;
        if (I + 2 < I1) {
            int s2, h2, r2; na_item(I + 2, s2, h2, r2); const int rows2 = seq_len(s2) >> 6, rsA2 = min(max(r2 - 4, 0), rows2 - 8), rsB2 = min(max(r2 - 3, 0), rows2 - 8);
            if (s2 == s && h2 == h && rsA2 <= hi && rsA2 + 9 >= hi && rsB2 + 8 > hi) { prow = hi;
#pragma unroll
                for (int j = 0; j < 2; ++j) { const int kr = min(hi + j, rows - 1), tok0 = st + kr * 64;
                    pk[j] = *(const u32x4*)(P + (size_t)(tok0 + ckey) * INW + 3584 + h * 64 + 8 * cch); pv[j] = *(const u32x4*)(PT + (size_t)(1024 + h * 64 + ckey) * MTOK + tok0 + 8 * cch); } } }
        const int rq = r + it, rs = it ? rsB : rsA;
        const int qtok = st + rq * 64 + 16 * qb + x;
        const bf16x8 q0 = *(const bf16x8*)(P + (size_t)qtok * INW + 3072 + h * 64 + 8 * g), q1 = *(const bf16x8*)(P + (size_t)qtok * INW + 3072 + h * 64 + 32 + 8 * g);
        __syncthreads();
        f32x4 S[16];
#pragma unroll
        for (int T = 0; T < 16; ++T) { const LAS unsigned char* kp = kr_ + ((rs + (T >> 1)) % NA_SLOTS) * NAK_ROW + (w0 + 16 * (T & 1) + x) * NAK_PITCH + 16 * g;
            f32x4 a = (f32x4){0.f, 0.f, 0.f, 0.f}; a = mfma16(*(const LAS bf16x8*)kp, q0, a); a = mfma16(*(const LAS bf16x8*)(kp + 64), q1, a); S[T] = a; }
        const int c = 16 * qb + x, cst = min(max(c - 8, 0), 48); float mx = -3.0e38f;
#pragma unroll
        for (int T = 0; T < 16; ++T) { const int dr = (rs + (T >> 1) - rq) + 7; const LAS float* rb = rl + dr * 31;
#pragma unroll
            for (int e = 0; e < 4; ++e) { const int kc = w0 + 16 * (T & 1) + 4 * g + e; const bool ok = (kc >= cst) && (kc < cst + 16); const int dc = min(max(kc - c, -15), 15) + 15;
                const float v = ok ? S[T][e] * 0.125f + rb[dc] : -1.0e30f; S[T][e] = v; mx = fmaxf(mx, v); } }
        mx = fmaxf(mx, __shfl_xor(mx, 16)); mx = fmaxf(mx, __shfl_xor(mx, 32));
        float sum = 0.f;
#pragma unroll
        for (int T = 0; T < 16; ++T)
#pragma unroll
            for (int e = 0; e < 4; ++e) { const float p = fast_exp(S[T][e] - mx); S[T][e] = p; sum += p; }
        sum += __shfl_xor(sum, 16); sum += __shfl_xor(sum, 32);
        const float inv = fast_rcp(sum);
        f32x4 O[4];
#pragma unroll
        for (int e2 = 0; e2 < 4; ++e2) O[e2] = (f32x4){0.f, 0.f, 0.f, 0.f};
#pragma unroll
        for (int ks = 0; ks < 8; ++ks) {
            u32x4 pw; pw.x = cvt_pk_bf16(S[2 * ks][0], S[2 * ks][1]); pw.y = cvt_pk_bf16(S[2 * ks][2], S[2 * ks][3]); pw.z = cvt_pk_bf16(S[2 * ks + 1][0], S[2 * ks + 1][1]); pw.w = cvt_pk_bf16(S[2 * ks + 1][2], S[2 * ks + 1][3]);
            const bf16x8 pf = __builtin_bit_cast(bf16x8, pw); const int kb = (((rs + ks) % NA_SLOTS) * 64 + w0 + 4 * g) * 2;
#pragma unroll
            for (int e2 = 0; e2 < 4; ++e2) { const LAS unsigned char* vp = vr_ + (16 * e2 + x) * NAV_PITCH + kb; const u32x2 lo = *(const LAS u32x2*)vp, hi2 = *(const LAS u32x2*)(vp + 32);
                u32x4 vw; vw.x = lo.x; vw.y = lo.y; vw.z = hi2.x; vw.w = hi2.y; O[e2] = mfma16(__builtin_bit_cast(bf16x8, vw), pf, O[e2]); } }
#pragma unroll
        for (int e2 = 0; e2 < 4; ++e2) { u32x2 w; w.x = cvt_pk_bf16(O[e2][0] * inv, O[e2][1] * inv); w.y = cvt_pk_bf16(O[e2][2] * inv, O[e2][3] * inv);
            *(u32x2*)(BR + (size_t)qtok * D + 1536 + h * 64 + 16 * e2 + 4 * g) = w; }
    }
    __syncthreads();
}
__device__ __forceinline__ float log2_sigmoid(float x) { return -__builtin_amdgcn_logf(1.0f + __builtin_amdgcn_exp2f(-x * 1.4426950408889634f)); }
constexpr int RT_PITCH = 272, RT_TILE = 128 * RT_PITCH;
__device__ __forceinline__ void decode_chunk(int u, int& s, int& h, int& n) { if (u < 512) { s = u >> 8; h = (u >> 6) & 3; n = u & 63; } else { const int v = u - 512; s = 2 + (v >> 7); h = (v >> 5) & 3; n = v & 31; } }
__device__ __forceinline__ void tile_load4(const bf16_t* src, size_t src_pitch, int tid, u32x4 (&v)[4]) {
#pragma unroll
    for (int i = 0; i < 4; ++i) { const int idx = tid + 512 * i, r = idx >> 4, ch = idx & 15; v[i] = *(const u32x4*)(src + (size_t)r * src_pitch + ch * 8); }
}
__device__ __forceinline__ void tile_store4(LAS unsigned char* dst, int tid, const u32x4 (&v)[4]) {
#pragma unroll
    for (int i = 0; i < 4; ++i) { const int idx = tid + 512 * i, r = idx >> 4, ch = idx & 15; *(LAS u32x4*)(dst + r * RT_PITCH + ch * 16) = v[i]; }
}
#define LDS_FRAG(tile, row, col) (*(const LAS bf16x8*)((tile) + (row) * RT_PITCH + (col) * 2))
__device__ __forceinline__ void ret_kv_phase(Frame& F, int l, const float* decay_f, const float* decay_b) {
    const bf16_t* P = (const bf16_t*)(F.ws + WS_P); const bf16_t* PT = (const bf16_t*)(F.ws + WS_PT); bf16_t* KV = (bf16_t*)(F.ws + WS_KV);
    const int lane = F.lane, x = lane & 15, g = lane >> 4, et = F.wave;
    LAS unsigned char* tK = F.lds; LAS unsigned char* tV = F.lds + RT_TILE;
    const int nun = (768 - F.bid + F.G - 1) / F.G;
#pragma unroll 1
    for (int ui_ = 0; ui_ < nun; ++ui_) { const int u = F.bid + ui_ * F.G;
        int s, h, n; decode_chunk(u, s, h, n); const int j0 = seq_start(s) + 128 * n;
        const float lgf = log2_sigmoid(decay_f[l * 4 + h]), lgb = log2_sigmoid(decay_b[l * 4 + h]);
        u32x4 a[4], b[4];
        tile_load4(P + (size_t)j0 * INW + 1536 + h * 128, INW, F.tid, a); tile_load4(PT + (size_t)(512 + h * 128) * MTOK + j0, MTOK, F.tid, b);
        __syncthreads();
        tile_store4(tK, F.tid, a); tile_store4(tV, F.tid, b);
        __syncthreads();
        f32x4 af[8], ab[8];
#pragma unroll
        for (int dt = 0; dt < 8; ++dt) { af[dt] = (f32x4){0.f, 0.f, 0.f, 0.f}; ab[dt] = (f32x4){0.f, 0.f, 0.f, 0.f}; }
#pragma unroll
        for (int ks = 0; ks < 4; ++ks) {
            const u32x4 vw = *(const LAS u32x4*)(tV + (16 * et + x) * RT_PITCH + (32 * ks + 8 * g) * 2);
            float v[8] = {bflo(vw.x), bfhi(vw.x), bflo(vw.y), bfhi(vw.y), bflo(vw.z), bfhi(vw.z), bflo(vw.w), bfhi(vw.w)}; float vf[8], vb[8];
#pragma unroll
            for (int e = 0; e < 8; ++e) { const int j = 32 * ks + 8 * g + e; vf[e] = v[e] * __builtin_amdgcn_exp2f(lgf * (float)(127 - j)); vb[e] = v[e] * __builtin_amdgcn_exp2f(lgb * (float)j); }
            u32x4 wf, wb; wf.x = cvt_pk_bf16(vf[0], vf[1]); wf.y = cvt_pk_bf16(vf[2], vf[3]); wf.z = cvt_pk_bf16(vf[4], vf[5]); wf.w = cvt_pk_bf16(vf[6], vf[7]);
            wb.x = cvt_pk_bf16(vb[0], vb[1]); wb.y = cvt_pk_bf16(vb[2], vb[3]); wb.z = cvt_pk_bf16(vb[4], vb[5]); wb.w = cvt_pk_bf16(vb[6], vb[7]);
            const bf16x8 bfv = __builtin_bit_cast(bf16x8, wf), bbv = __builtin_bit_cast(bf16x8, wb);
#pragma unroll
            for (int dt = 0; dt < 8; ++dt) {
                const LAS unsigned char* kp = tK + (32 * ks + 8 * g + (x >> 2)) * RT_PITCH + (16 * dt + 4 * (x & 3)) * 2;
                const bf16x4 k0 = __builtin_amdgcn_ds_read_tr16_b64_v4i16((LAS bf16x4*)kp), k1 = __builtin_amdgcn_ds_read_tr16_b64_v4i16((LAS bf16x4*)(kp + 4 * RT_PITCH));
                const bf16x8 kf = __builtin_shufflevector(k0, k1, 0, 1, 2, 3, 4, 5, 6, 7); af[dt] = mfma16(kf, bfv, af[dt]); ab[dt] = mfma16(kf, bbv, ab[dt]); }
        }
        bf16_t* o = KV + (size_t)u * 2 * 16384 + (size_t)(16 * et + x) * 128 + 4 * g;
#pragma unroll
        for (int dt = 0; dt < 8; ++dt) { u32x2 wf, wb; wf.x = cvt_pk_bf16(af[dt][0], af[dt][1]); wf.y = cvt_pk_bf16(af[dt][2], af[dt][3]); wb.x = cvt_pk_bf16(ab[dt][0], ab[dt][1]); wb.y = cvt_pk_bf16(ab[dt][2], ab[dt][3]);
            *(u32x2*)(o + 16 * dt) = wf; *(u32x2*)(o + 16384 + 16 * dt) = wb; }
    }
    __syncthreads();
}
__device__ __forceinline__ void ret_scan_phase(Frame& F, int l, const float* decay_f, const float* decay_b) {
    const bf16_t* KV = (const bf16_t*)(F.ws + WS_KV); bf16_t* RT = (bf16_t*)(F.ws + WS_RT);
    for (int it = F.bid * NTHREADS + F.tid; it < 16 * 2 * 4096; it += F.G * NTHREADS) {
        const int q = it & 4095, dir = (it >> 12) & 1, sh = it >> 13, s = sh >> 2, h = sh & 3; const int N = seq_len(s) >> 7; const int ubase = s < 2 ? s * 256 + h * 64 : 512 + (s - 2) * 128 + h * 32;
        const float lg = log2_sigmoid((dir ? decay_b : decay_f)[l * 4 + h]); const float cd = __builtin_amdgcn_exp2f(lg * 128.0f);
        f32x4 stv = (f32x4){0.f, 0.f, 0.f, 0.f};
#pragma unroll 1
        for (int k0 = 0; k0 < N; k0 += 8) { u32x2 kv[8]; size_t off[8];
#pragma unroll
            for (int j = 0; j < 8; ++j) { const int k = k0 + j, n = dir ? (N - 1 - k) : k; off[j] = ((size_t)(ubase + n) * 2 + dir) * 16384 + (size_t)q * 4; kv[j] = *(const u32x2*)(KV + off[j]); }
#pragma unroll
            for (int j = 0; j < 8; ++j) { u32x2 w; w.x = cvt_pk_bf16(stv[0], stv[1]); w.y = cvt_pk_bf16(stv[2], stv[3]); *(u32x2*)(RT + off[j]) = w; stv = stv * cd + (f32x4){bflo(kv[j].x), bfhi(kv[j].x), bflo(kv[j].y), bfhi(kv[j].y)}; } }
    }
}
__device__ __forceinline__ void ret_out_phase(Frame& F, int l, const float* decay_f, const float* decay_b) {
    const bf16_t* P = (const bf16_t*)(F.ws + WS_P); const bf16_t* PT = (const bf16_t*)(F.ws + WS_PT); const bf16_t* RT = (const bf16_t*)(F.ws + WS_RT); bf16_t* BR = (bf16_t*)(F.ws + WS_BR);
    const int lane = F.lane, x = lane & 15, g = lane >> 4, ti = F.wave;
    LAS unsigned char* tK = F.lds; LAS unsigned char* tV = F.lds + RT_TILE; LAS unsigned char* tF = F.lds + 2 * RT_TILE; LAS unsigned char* tB = F.lds + 3 * RT_TILE;
    LAS unsigned char* pl = tK + 16 * ti * RT_PITCH;
    const int nun = (768 - F.bid + F.G - 1) / F.G;
#pragma unroll 1
    for (int ui_ = 0; ui_ < nun; ++ui_) { const int u = F.bid + ui_ * F.G;
        int s, h, n; decode_chunk(u, s, h, n);
        const int j0 = seq_start(s) + 128 * n, il = 16 * ti + x, itok = j0 + il;
        const float lgf = log2_sigmoid(decay_f[l * 4 + h]), lgb = log2_sigmoid(decay_b[l * 4 + h]);
        u32x4 a[4], b[4], c[4], d[4]; bf16x8 qf[4]; u32x2 gw[8];
        tile_load4(P + (size_t)j0 * INW + 1536 + h * 128, INW, F.tid, a); tile_load4(PT + (size_t)(512 + h * 128) * MTOK + j0, MTOK, F.tid, b);
        tile_load4(RT + (size_t)u * 2 * 16384, 128, F.tid, c); tile_load4(RT + (size_t)u * 2 * 16384 + 16384, 128, F.tid, d);
#pragma unroll
        for (int ks = 0; ks < 4; ++ks) qf[ks] = *(const bf16x8*)(P + (size_t)itok * INW + 1024 + h * 128 + 32 * ks + 8 * g);
#pragma unroll
        for (int et = 0; et < 8; ++et) gw[et] = *(const u32x2*)(P + (size_t)itok * INW + 2560 + h * 128 + 16 * et + 4 * g);
        __syncthreads();
        tile_store4(tK, F.tid, a); tile_store4(tV, F.tid, b); tile_store4(tF, F.tid, c); tile_store4(tB, F.tid, d);
        __syncthreads();
        f32x4 S[8];
#pragma unroll
        for (int jt = 0; jt < 8; ++jt) { f32x4 acc = (f32x4){0.f, 0.f, 0.f, 0.f};
#pragma unroll
            for (int ks = 0; ks < 4; ++ks) acc = mfma16(LDS_FRAG(tK, 16 * jt + x, 32 * ks + 8 * g), qf[ks], acc);
#pragma unroll
            for (int e = 0; e < 4; ++e) { const int dl = il - (16 * jt + 4 * g + e); acc[e] *= dl >= 0 ? __builtin_amdgcn_exp2f(lgf * (float)dl) : __builtin_amdgcn_exp2f(lgb * (float)(-dl)); }
            S[jt] = acc; }
        f32x4 O[8];
        const float cf = __builtin_amdgcn_exp2f(lgf * (float)(il + 1)), cb = __builtin_amdgcn_exp2f(lgb * (float)(128 - il));
#pragma unroll
        for (int et = 0; et < 8; ++et) { f32x4 xf = (f32x4){0.f, 0.f, 0.f, 0.f}, xb = (f32x4){0.f, 0.f, 0.f, 0.f};
#pragma unroll
            for (int ks = 0; ks < 4; ++ks) { xf = mfma16(LDS_FRAG(tF, 16 * et + x, 32 * ks + 8 * g), qf[ks], xf); xb = mfma16(LDS_FRAG(tB, 16 * et + x, 32 * ks + 8 * g), qf[ks], xb); }
            O[et] = xf * cf + xb * cb; }
        __syncthreads();
#pragma unroll
        for (int jt = 0; jt < 8; ++jt) { u32x2 w; w.x = cvt_pk_bf16(S[jt][0], S[jt][1]); w.y = cvt_pk_bf16(S[jt][2], S[jt][3]); *(LAS u32x2*)(pl + x * RT_PITCH + (16 * jt + 4 * g) * 2) = w; }
#pragma unroll
        for (int ks = 0; ks < 4; ++ks) { const bf16x8 pf = LDS_FRAG(pl, x, 32 * ks + 8 * g);
#pragma unroll
            for (int et = 0; et < 8; ++et) O[et] = mfma16(LDS_FRAG(tV, 16 * et + x, 32 * ks + 8 * g), pf, O[et]); }
        float sm = 0.f;
#pragma unroll
        for (int et = 0; et < 8; ++et) sm += (O[et][0] + O[et][1]) + (O[et][2] + O[et][3]);
        sm += __shfl_xor(sm, 16); sm += __shfl_xor(sm, 32); const float mu = sm * (1.0f / 128.0f);
        float vq = 0.f;
#pragma unroll
        for (int et = 0; et < 8; ++et) { const f32x4 dd = O[et] - mu; vq += (dd[0] * dd[0] + dd[1] * dd[1]) + (dd[2] * dd[2] + dd[3] * dd[3]); }
        vq += __shfl_xor(vq, 16); vq += __shfl_xor(vq, 32); const float rstd = __builtin_amdgcn_rsqf(vq * (1.0f / 128.0f) + EPS);
#pragma unroll
        for (int et = 0; et < 8; ++et) { const float g0 = bflo(gw[et].x), g1 = bfhi(gw[et].x), g2 = bflo(gw[et].y), g3 = bfhi(gw[et].y);
            u32x2 w; w.x = cvt_pk_bf16((O[et][0] - mu) * rstd * g0 * sigmoidf_(g0), (O[et][1] - mu) * rstd * g1 * sigmoidf_(g1)); w.y = cvt_pk_bf16((O[et][2] - mu) * rstd * g2 * sigmoidf_(g2), (O[et][3] - mu) * rstd * g3 * sigmoidf_(g3));
            *(u32x2*)(BR + (size_t)itok * D + 1024 + h * 128 + 16 * et + 4 * g) = w; }
    }
    __syncthreads();
}

#define I_X_PROMPT (ap_->in[0])
#define I_X_SAMPLE (ap_->in[1])
#define I_C_PROMPT (ap_->in[2])
#define I_C_SAMPLE (ap_->in[3])
#define I_W_ADA (ap_->in[4])
#define I_B_ADA (ap_->in[5])
#define I_G_MIX (ap_->in[6])
#define I_W_IN (ap_->in[7])
#define I_POOL_W (ap_->in[8])
#define I_POOL_SCALE (ap_->in[9])
#define I_DECAY_F (ap_->in[10])
#define I_DECAY_B (ap_->in[11])
#define I_RPB (ap_->in[12])
#define I_W_BRANCH (ap_->in[13])
#define I_W_GATE (ap_->in[14])
#define I_B_GATE (ap_->in[15])
#define I_W_OUT (ap_->in[16])
#define I_G_FFN (ap_->in[17])
#define I_W_UP (ap_->in[18])
#define I_CONV_W (ap_->in[19])
#define I_CONV_B (ap_->in[20])
#define I_W_DOWN (ap_->in[21])
#define I_G_FINAL (ap_->in[22])
constexpr int PH_PER_LAYER = 11, PH_TOTAL = 2 + DEPTH * PH_PER_LAYER + 1;
__global__ void __launch_bounds__(NTHREADS, 2) fwd_kernel(Args args) {
    extern __shared__ __attribute__((aligned(16))) unsigned char lds_raw[];
    volatile LAS unsigned* MISC = (volatile LAS unsigned*)((LAS unsigned char*)lds_raw + LDS_MISC);
    if (threadIdx.x < 4) MISC[threadIdx.x] = 0u;
    __syncthreads();
    if (MK_N_LAUNCHES == 1) (void)xcd_barrier_post((unsigned*)(args.ws + WS_CTL) + 4096, MISC);
#if MK_N_LAUNCHES == 1
#define IN_PH() true
#define END_PH() do { XcdBarrier bar_; bar_.bar = (unsigned*)(args.ws + WS_CTL) + 4096; bar_.x = xb_xcc_id(); bar_.st = (volatile LAS unsigned*)((LAS unsigned char*)lds_raw + LDS_MISC); xcd_barrier(bar_); } while (0)
#else
    const int lo = args.ph_lo, hi = args.ph_hi; int ph = 0;
#define IN_PH() (lo <= ph && ph < hi)
#define END_PH() do { if (IN_PH() && ph + 1 < hi) { XcdBarrier bar_; bar_.bar = (unsigned*)(args.ws + WS_CTL) + 4096; bar_.x = xb_xcc_id(); bar_.st = (volatile LAS unsigned*)((LAS unsigned char*)lds_raw + LDS_MISC); xcd_barrier(bar_); } ++ph; } while (0)
#endif
#define PH_FRAME() Frame F; const __attribute__((address_space(4))) Args* ap_ = (const __attribute__((address_space(4))) Args*)__builtin_amdgcn_kernarg_segment_ptr(); asm volatile("" : "+s"(ap_)); \
        { int t_ = threadIdx.x; asm volatile("" : "+v"(t_)); unsigned char* w_ = ap_->ws; float* o_ = ap_->out; \
        unsigned l_ = 0; asm volatile("" : "+s"(l_)); F.lds = (LAS unsigned char*)lds_raw + l_; F.tid = t_; F.lane = t_ & 63; F.wave = __builtin_amdgcn_readfirstlane(t_ >> 6); int g_ = gridDim.x, b_ = blockIdx.x; asm volatile("" : "+s"(g_)); asm volatile("" : "+s"(b_)); F.G = g_; F.bid = b_; \
        F.gw = b_ * NWAVES + F.wave; F.NGW = F.G * NWAVES; F.out = o_; F.ws = w_; } \
        const float* mod = (const float*)(F.ws + WS_MOD); const int c = F.bid; (void)mod; (void)c; int l = l0; asm volatile("" : "+s"(l)); (void)l

    { const int l0 = 0;
    if (IN_PH()) { PH_FRAME(); prologue_mod_partial(F, I_C_PROMPT, I_C_SAMPLE, I_W_ADA); prologue_tables(F); convert_weights(F, 0, I_W_IN, I_W_GATE, I_W_BRANCH, I_W_OUT, I_W_UP, I_W_DOWN, I_POOL_W, I_POOL_SCALE, false); }
    END_PH();
    if (IN_PH()) { PH_FRAME(); prologue_mod_reduce(F, I_B_ADA); }
    END_PH(); }
#pragma unroll 1
    for (int l0 = 0; l0 < DEPTH; ++l0) {
#define LAYER_PTRS() const float* mod_l = mod + (size_t)l * 4 * 12288; const float* xp = (l == 0) ? I_X_PROMPT : F.out; const float* xs = (l == 0) ? I_X_SAMPLE - (size_t)16384 * D : F.out; (void)mod_l; (void)xp; (void)xs
        if (IN_PH()) { PH_FRAME(); LAYER_PTRS(); if (l > 0) convert_weights(F, l, I_W_IN, I_W_GATE, I_W_BRANCH, I_W_OUT, I_W_UP, I_W_DOWN, I_POOL_W, I_POOL_SCALE, true); __syncthreads(); if (l == 0) norm_phase<true>(F, xp, xs, I_G_MIX + (size_t)l * D, mod_l, 0, D); else norm_phase<false>(F, xp, xs, I_G_MIX + (size_t)l * D, mod_l, 0, D); }
        END_PH();
        if (IN_PH()) { PH_FRAME(); SchedG1 S{F.G, c, (const char*)(F.ws + WS_H), (const char*)(F.ws + WS_W1T)};
            EpiG1 E{(bf16_t*)(F.ws + WS_P), (bf16_t*)(F.ws + WS_PT), (bf16_t*)(F.ws + WS_GATES), I_B_GATE + (size_t)l * NGATE, (const float*)(F.ws + WS_ROPEC), (const float*)(F.ws + WS_ROPES), (const float*)(F.ws + WS_ROPECT), (const float*)(F.ws + WS_ROPEST)};
            pg8::gemm_phase<EpiG1, SchedG1>(F.lds, F.tid, 4096u, 4096u, (size_t)128 * 4096u, (size_t)128 * 4096u, S, E);
            convert_tail(F, l, I_W_IN, I_W_GATE, I_W_BRANCH, I_W_OUT, I_W_UP, I_W_DOWN, 96 * 50, CV_A, CV_QG1); }
        END_PH();
        if (IN_PH()) { { PH_FRAME(); SchedCDFT S{F.G, c, (const char*)(F.ws + WS_D2), (const char*)(F.ws + WS_P), 1}; EpiCDFT E{(bf16_t*)(F.ws + WS_YT)}; pg8::gemm_phase<EpiCDFT, SchedCDFT>(F.lds, F.tid, 256u, (unsigned)(64 * INW * 2), (size_t)128 * 256, (size_t)(INW * 2), S, E); }
            { PH_FRAME(); SchedCDFT S{F.G, c, (const char*)(F.ws + WS_D2), (const char*)(F.ws + WS_P), 0}; EpiCDFT E{(bf16_t*)(F.ws + WS_YT)}; pg8::gemm_phase<EpiCDFT, SchedCDFT>(F.lds, F.tid, 256u, (unsigned)(32 * INW * 2), (size_t)128 * 256, (size_t)(INW * 2), S, E); }
            { PH_FRAME(); pool_phase(F); }
            { PH_FRAME(); ret_kv_phase(F, l, I_DECAY_F, I_DECAY_B); }
            { PH_FRAME(); na_phase(F, l, I_RPB, 0); } }
        END_PH();
        if (IN_PH()) { { PH_FRAME(); ret_scan_phase(F, l, I_DECAY_F, I_DECAY_B); }
            { PH_FRAME(); SchedF1 S{F.G, c, (const char*)(F.ws + WS_A1), (const char*)(F.ws + WS_YT)}; EpiF1 E{(bf16_t*)(F.ws + WS_ZT), (const float*)(F.ws + WS_TWL), (const float*)(F.ws + WS_TWS)}; pg8::gemm_phase<EpiF1, SchedF1>(F.lds, F.tid, 512u, 512u, (size_t)128 * 512, (size_t)128 * 512, S, E); }
            { PH_FRAME(); na_phase(F, l, I_RPB, 1); } }
        END_PH();
        if (IN_PH()) { { PH_FRAME(); SchedF2 S{F.G, c, (const char*)(F.ws + WS_A2L), (const char*)(F.ws + WS_A2S), (const char*)(F.ws + WS_ZT)}; EpiF2 E{(bf16_t*)(F.ws + WS_BR)}; pg8::gemm_phase<EpiF2, SchedF2>(F.lds, F.tid, 256u, 256u, (size_t)128 * 256, (size_t)128 * 256, S, E); }
            { PH_FRAME(); ret_out_phase(F, l, I_DECAY_F, I_DECAY_B); } }
        END_PH();
        if (IN_PH()) {
            { PH_FRAME(); SchedMerge S{F.G, c, (const char*)(F.ws + WS_BR), (const char*)(F.ws + WS_WBRT)}; EpiMerge E{(bf16_t*)(F.ws + WS_MERGED), (const bf16_t*)(F.ws + WS_GATES), (const bf16_t*)(F.ws + WS_ZERO)}; pg8::gemm_phase<EpiMerge, SchedMerge>(F.lds, F.tid, 4096u, 1024u, (size_t)128 * 4096u, (size_t)128 * 1024u, S, E); } }
        END_PH();
        if (IN_PH()) { PH_FRAME(); LAYER_PTRS(); SchedPlain S{F.G, c, (const char*)(F.ws + WS_MERGED), (const char*)(F.ws + WS_WOUTT), 8, 32, 4096}; EpiRes E{(bf16_t*)(F.ws + WS_XB), mod_l + 2 * D};
            pg8::gemm_phase<EpiRes, SchedPlain>(F.lds, F.tid, 4096u, 4096u, (size_t)128 * 4096u, (size_t)128 * 4096u, S, E); }
        END_PH();
        if (IN_PH()) { PH_FRAME(); LAYER_PTRS(); norm_phase<false>(F, nullptr, nullptr, I_G_FFN + (size_t)l * D, mod_l, 3 * D, 4 * D); }
        END_PH();
        if (IN_PH()) { PH_FRAME(); SchedPlain S{F.G, c, (const char*)(F.ws + WS_H), (const char*)(F.ws + WS_WUPT), 44, 32, 4096}; EpiUpConv E{(bf16_t*)(F.ws + WS_ACT), (bf16_t*)(F.ws + WS_Y), I_CONV_W + (size_t)l * 3 * NUP, I_CONV_B + (size_t)l * NUP, F.lds + pg8::STAGE_BYTES};
            pg8::gemm_phase<EpiUpConv, SchedPlain>(F.lds, F.tid, 4096u, 4096u, (size_t)128 * 4096u, (size_t)128 * 4096u, S, E);
            if (l + 1 < DEPTH) convert_tail(F, l + 1, I_W_IN, I_W_GATE, I_W_BRANCH, I_W_OUT, I_W_UP, I_W_DOWN, 96 * 44, 0, CV_QUP); }
        END_PH();
        if (IN_PH()) { PH_FRAME(); conv_fix_phase(F, l, I_CONV_W, I_CONV_B); }
        END_PH();
        if (IN_PH()) { PH_FRAME(); LAYER_PTRS(); SchedPlain S{F.G, c, (const char*)(F.ws + WS_ACT), (const char*)(F.ws + WS_WDNT), 8, 88, 11264}; EpiRes E{(bf16_t*)(F.ws + WS_XB), mod_l + 5 * D};
            pg8::gemm_phase<EpiRes, SchedPlain>(F.lds, F.tid, 11264u, 11264u, (size_t)128 * 11264u, (size_t)128 * 11264u, S, E); }
        END_PH();
    }
    { const int l0 = 0; if (IN_PH()) { PH_FRAME(); final_norm_phase(F, I_G_FINAL); } }
#undef IN_PH
#undef END_PH
}

#ifdef DBG_CUT
__global__ void dbg_dump(const unsigned short* src, float* out, size_t n) { for (size_t i = (size_t)blockIdx.x * blockDim.x + threadIdx.x; i < n; i += (size_t)gridDim.x * blockDim.x) out[i] = __uint_as_float(((unsigned)src[i]) << 16); }
#endif
extern "C" void kernel_launch(void* const* d_in, const int* in_sizes, int n_in, void* d_out, int out_size, void* d_ws, size_t ws_size, hipStream_t stream) {
    static int grid = 0;
    if (grid == 0) {
        if (n_in != 23 || out_size != MTOK * D || ws_size < WS_END) { fprintf(stderr, "kernel_launch: unexpected sizes (n_in %d, out %d, ws %zu; need ws >= %zu); nothing launched\n", n_in, out_size, ws_size, (size_t)WS_END); grid = -1; return; }
        int dev = 0, cus = 0, per_cu = 0;
        if (hipGetDevice(&dev) != hipSuccess || hipDeviceGetAttribute(&cus, hipDeviceAttributeMultiprocessorCount, dev) != hipSuccess) { grid = -1; return; }
        if (hipFuncSetAttribute((const void*)fwd_kernel, hipFuncAttributeMaxDynamicSharedMemorySize, LDS_BYTES) != hipSuccess) { fprintf(stderr, "kernel_launch: hipFuncSetAttribute failed\n"); grid = -1; return; }
        if (hipOccupancyMaxActiveBlocksPerMultiprocessor(&per_cu, (const void*)fwd_kernel, NTHREADS, LDS_BYTES) != hipSuccess || per_cu < 1) { fprintf(stderr, "kernel_launch: occupancy query says %d blocks per CU\n", per_cu); }
        (void)hipGetLastError();
        grid = cus;
    }
    if (grid < 0) return;
    (void)hipMemsetAsync((char*)d_ws + WS_CTL, 0, CTL_ZERO_BYTES, stream);
#ifdef DBG_CLEAR_ALL
    (void)hipMemsetAsync((char*)d_ws + CTL_ZERO_BYTES, 0, WS_END - CTL_ZERO_BYTES, stream); (void)hipMemsetAsync(d_out, 0, (size_t)out_size * 4, stream);
#endif
    Args a{};
    for (int i = 0; i < 23; ++i) a.in[i] = (const float*)d_in[i];
    a.out = (float*)d_out; a.ws = (unsigned char*)d_ws;
#if MK_N_LAUNCHES == 1
    a.ph_lo = 0; a.ph_hi = PH_TOTAL;
    hipLaunchKernelGGL(fwd_kernel, dim3(grid), dim3(NTHREADS), LDS_BYTES, stream, a);
#else
#ifdef DBG_CUT
    for (int p = 0; p < DBG_CUT; ++p) { a.ph_lo = p; a.ph_hi = p + 1; hipLaunchKernelGGL(fwd_kernel, dim3(grid), dim3(NTHREADS), LDS_BYTES, stream, a); }
    hipLaunchKernelGGL(dbg_dump, dim3(2048), dim3(256), 0, stream, (const unsigned short*)((char*)d_ws + DBG_OFF), (float*)d_out, (size_t)DBG_N);
#else
    for (int p = 0; p < PH_TOTAL; ++p) { a.ph_lo = p; a.ph_hi = p + 1; hipLaunchKernelGGL(fwd_kernel, dim3(grid), dim3(NTHREADS), LDS_BYTES, stream, a); }
#endif
#endif
}
```

```cpp
#include <hip/hip_runtime.h>
#include <cstdio>
#include <cstdint>

#define LAS __attribute__((address_space(3)))
typedef unsigned short bf16_t;
typedef short bf16x8 __attribute__((ext_vector_type(8)));
typedef short bf16x4 __attribute__((ext_vector_type(4)));
typedef float f32x4 __attribute__((ext_vector_type(4)));
typedef float f32x2 __attribute__((ext_vector_type(2)));
typedef unsigned u32x4 __attribute__((ext_vector_type(4)));
typedef unsigned u32x2 __attribute__((ext_vector_type(2)));

#ifndef REP_MIX
#define REP_MIX 1
#endif
#ifndef REP_ELT
#define REP_ELT 1
#endif
#ifndef REP_DFT
#define REP_DFT 1
#endif
#ifndef REP_G1
#define REP_G1 1
#endif
#ifndef REP_UP
#define REP_UP 1
#endif
#define REPEAT(n) _Pragma("unroll 1") for (int r_ = 0; r_ < (n); ++r_)
#ifndef MK_N_LAUNCHES
#define MK_N_LAUNCHES 1
#endif

constexpr int D = 2048, DEPTH = 4, NSEQ = 4, MTOK = 24576;
constexpr int INW = 4608, DFF = 5632, NUP = 11264, NGATE = 8192;
constexpr int NWAVES = 8, NTHREADS = 512;
constexpr int LDS_BYTES = 163840, LDS_MISC = LDS_BYTES - 256;
constexpr float EPS = 1e-6f;

__host__ __device__ __forceinline__ int seq_start(int s) { return s < 2 ? s * 8192 : 16384 + (s - 2) * 4096; }
__host__ __device__ __forceinline__ int seq_len(int s) { return s < 2 ? 8192 : 4096; }
__host__ __device__ __forceinline__ int seq_of_row(int m) { return m < 16384 ? (m >> 13) : 2 + ((m - 16384) >> 12); }

constexpr size_t MiB = 1u << 20;
constexpr size_t WS_CTL = 0, CTL_ZERO_BYTES = 1 * MiB, WS_ZERO = 512 * 1024;
constexpr size_t WS_MOD = 1 * MiB;
constexpr size_t WS_MODP = 1318 * MiB;
constexpr size_t WS_ROPEC = 8 * MiB, WS_ROPES = 10 * MiB, WS_ROPECT = 12 * MiB, WS_ROPEST = 14 * MiB;
constexpr size_t WS_D2 = 16 * MiB;
constexpr size_t WS_A1 = WS_D2 + 256 * 1024;
constexpr size_t WS_A2L = WS_D2 + 512 * 1024;
constexpr size_t WS_A2S = WS_D2 + 640 * 1024;
constexpr size_t WS_TWL = WS_D2 + 768 * 1024;
constexpr size_t WS_TWS = WS_D2 + 896 * 1024;
constexpr size_t WS_ZT = 18 * MiB;
constexpr size_t WS_W1T = 274 * MiB;
constexpr size_t WS_WBRT = 324 * MiB;
constexpr size_t WS_WOUTT = 332 * MiB;
constexpr size_t WS_WUPT = 340 * MiB;
constexpr size_t WS_WDNT = 384 * MiB;
constexpr size_t WS_H = 406 * MiB;
constexpr size_t WS_P = 502 * MiB;
constexpr size_t WS_PT = 718 * MiB;
constexpr size_t WS_GATES = 790 * MiB;
constexpr size_t WS_BR = 1174 * MiB;
constexpr size_t WS_YT = 1270 * MiB;
constexpr size_t WS_KV = 1318 * MiB;
constexpr size_t WS_RT = 1414 * MiB;
constexpr size_t WS_MERGED = 1270 * MiB;
constexpr size_t WS_Y = 502 * MiB;
constexpr size_t WS_ACT = 1030 * MiB;
constexpr size_t WS_XB = 1462 * MiB;
constexpr size_t WS_END = 1558 * MiB;

typedef __bf16 bf16x2v __attribute__((ext_vector_type(2)));
__device__ __forceinline__ unsigned cvt_pk_bf16(float lo, float hi) { const f32x2 v = {lo, hi}; const bf16x2v b = __builtin_convertvector(v, bf16x2v); return __builtin_bit_cast(unsigned, b); }
__device__ __forceinline__ float bf2f(unsigned short b) { return __uint_as_float(((unsigned)b) << 16); }
__device__ __forceinline__ float bflo(unsigned w) { return __uint_as_float(w << 16); }
__device__ __forceinline__ float bfhi(unsigned w) { return __uint_as_float(w & 0xffff0000u); }
__device__ __forceinline__ float wave_sum(float v) {
#pragma unroll
    for (int o = 1; o < 64; o <<= 1) v += __shfl_xor(v, o);
    return v;
}
__device__ __forceinline__ float fast_exp(float x) { return __builtin_amdgcn_exp2f(x * 1.4426950408889634f); }
__device__ __forceinline__ float fast_rcp(float x) { return __builtin_amdgcn_rcpf(x); }
__device__ __forceinline__ float sigmoidf_(float x) { return fast_rcp(1.0f + fast_exp(-x)); }
constexpr float NLOG2E = -1.4426950408889634f;
__device__ __forceinline__ float sig2_(float t) { return fast_rcp(1.0f + __builtin_amdgcn_exp2f(t)); }
__device__ __forceinline__ float gelu_tanh(float u) { const float a = u * (u * u * 0.10294324f + 2.3022082f); const float r = fast_rcp(1.0f + __builtin_amdgcn_exp2f(a)); return u - u * r; }
__device__ __forceinline__ float dpp_ror1(float v) { return __builtin_bit_cast(float, __builtin_amdgcn_mov_dpp(__builtin_bit_cast(int, v), 0x121, 0xf, 0xf, false)); }
__device__ __forceinline__ float dpp_ror15(float v) { return __builtin_bit_cast(float, __builtin_amdgcn_mov_dpp(__builtin_bit_cast(int, v), 0x12f, 0xf, 0xf, false)); }
__device__ __forceinline__ f32x4 mfma16(bf16x8 a, bf16x8 b, f32x4 c) { return __builtin_amdgcn_mfma_f32_16x16x32_bf16(a, b, c, 0, 0, 0); }

#define SCHED_FENCE() __builtin_amdgcn_sched_barrier(0)
#define XB_TMO      128
#define XB_XCNT(j)  (256  + 64 * (j))
#define XB_XSUB(j)  (1280 + 64 * (j))
#define XB_XGEN(j)  (2304 + 64 * (j))
#define XB_TOP      3328
#define XB_TOPGEN   3392
#define XCD_BAR_WORDS 3456
#define XB_SPIN_CAP (1u << 22)

__device__ __forceinline__ unsigned xb_ld(unsigned* p)              { return __hip_atomic_load(p, __ATOMIC_RELAXED, __HIP_MEMORY_SCOPE_AGENT); }
__device__ __forceinline__ unsigned xb_add(unsigned* p, unsigned v) { return __hip_atomic_fetch_add(p, v, __ATOMIC_RELAXED, __HIP_MEMORY_SCOPE_AGENT); }
__device__ __forceinline__ unsigned xb_xcc_id() { return (unsigned)__builtin_amdgcn_s_getreg((3 << 11) | 20) & 0xFu; }
#define XB_SPIN(cond, bar) do { unsigned _sp = 0; while (cond) { __builtin_amdgcn_s_sleep(1); \
    if ((++_sp & 255u) == 0u) { if (xb_ld(&(bar)[XB_TMO])) break; if (_sp > XB_SPIN_CAP) { atomicAdd(&(bar)[XB_TMO], 1u); break; } } } } while (0)

struct XcdBarrier {
    unsigned* bar; unsigned x;
    volatile LAS unsigned* st;
};
__device__ __forceinline__ XcdBarrier xcd_barrier_post(unsigned* bar, volatile LAS unsigned* st) {
    XcdBarrier b; b.bar = bar; b.x = xb_xcc_id(); b.st = st;
    if (threadIdx.x == 0) (void)xb_add(&bar[XB_XCNT(b.x)], 1u);
    return b;
}
__device__ __forceinline__ void xcd_barrier_complete(unsigned* bar, unsigned x, unsigned& nloc, unsigned& nx) {
    const unsigned G = gridDim.x * gridDim.y * gridDim.z;
    unsigned sum, cnt, mine, sp = 0u;
    for (;;) {
        sum = 0u; cnt = 0u; mine = 0u;
#pragma unroll
        for (unsigned j = 0; j < 16; ++j) { const unsigned c = xb_ld(&bar[XB_XCNT(j)]); sum += c; cnt += (c > 0u) ? 1u : 0u; mine = (j == x) ? c : mine; }
        if (sum == G) break;
        __builtin_amdgcn_s_sleep(1);
        if ((++sp & 255u) == 0u) { if (xb_ld(&bar[XB_TMO])) break; if (sp > XB_SPIN_CAP) { atomicAdd(&bar[XB_TMO], 1u); break; } }
    }
    nloc = mine > 0u ? mine : 1u; nx = cnt > 0u ? cnt : 1u;
}
__device__ __forceinline__ void xcd_barrier(const XcdBarrier& b) {
    asm volatile("s_waitcnt vmcnt(0)" ::: "memory");
    __syncthreads();
    if (threadIdx.x == 0) {
        unsigned* bar = b.bar;
        __builtin_amdgcn_s_waitcnt(0);
        unsigned nloc = b.st[0], nx = b.st[1];
        if (nloc == 0u) { xcd_barrier_complete(bar, b.x, nloc, nx); b.st[0] = nloc; b.st[1] = nx; }
        const unsigned old = xb_add(&bar[XB_XSUB(b.x)], 1u);
        const unsigned gen = old / nloc;
        if (old + 1u == (gen + 1u) * nloc) {
            __builtin_amdgcn_fence(__ATOMIC_RELEASE, "agent");
            asm volatile("s_waitcnt vmcnt(0)" ::: "memory");
            const unsigned og = xb_add(&bar[XB_TOP], 1u);
            const unsigned tg = og / nx;
            if (og + 1u == (tg + 1u) * nx) xb_add(&bar[XB_TOPGEN], 1u);
            else XB_SPIN(xb_ld(&bar[XB_TOPGEN]) == tg, bar);
            __builtin_amdgcn_fence(__ATOMIC_ACQUIRE, "agent");
            xb_add(&bar[XB_XGEN(b.x)], 1u);
            asm volatile("s_waitcnt vmcnt(0)" ::: "memory");
        } else {
            XB_SPIN(xb_ld(&bar[XB_XGEN(b.x)]) == gen, bar);
            __builtin_amdgcn_fence(__ATOMIC_ACQUIRE, "agent");
            asm volatile("s_waitcnt vmcnt(0)" ::: "memory");
        }
    }
    __syncthreads();
}

namespace pg8 {
constexpr int BM = 256, BK = 64, HALF = 128, HTB = HALF * BK * 2, STAGE_BYTES = 8 * HTB, NXCD = 8, WGM = 8;
__host__ __device__ __forceinline__ int lds_byte(int r, int c) { const int st = (r >> 4) * 2 + (c >> 5), rr = r & 15, cc = c & 31, ob = rr * 64 + cc * 2; return st * 1024 + (ob ^ (((ob >> 9) & 1) << 5)); }
__host__ __device__ __forceinline__ void stage_rc(int b, int& R, int& C) { const int st = b / 1024, sb = b % 1024, swz = sb ^ (((sb >> 9) & 1) << 5); R = (st >> 1) * 16 + swz / 64; C = (st & 1) * 32 + (swz % 64) / 2; }
__host__ __device__ __forceinline__ int perm32(int rho) { const int n = rho >> 4, i = rho & 15; return 8 * (i >> 2) + 4 * n + (i & 3); }

struct Unit { const char* A; const char* B; int nt, kind, r0, c0, dst; };
__device__ __forceinline__ bool tile_order(int i, int G, int c, int nM, int nN, int& pm, int& pn) {
    const int nwg = nM * nN; const long L = (long)i * G + c; if (L >= nwg) return false;
    int wgid = (int)L; { const int q = nwg / NXCD, r = nwg % NXCD, xcd = wgid % NXCD, off = wgid / NXCD; wgid = (xcd < r ? xcd * (q + 1) : r * (q + 1) + (xcd - r) * q) + off; }
    const int nig = WGM * nN, gid = wgid / nig, fm = gid * WGM, gsz = (nM - fm) < WGM ? (nM - fm) : WGM;
    pm = fm + ((wgid % nig) % gsz); pn = (wgid % nig) / gsz; return true;
}

template <class Epi, class Sched>
__device__ __forceinline__ void gemm_phase(LAS unsigned char* lds, const int tid, const unsigned lda, const unsigned ldb, const size_t hstepA, const size_t hstepB, const Sched& S, const Epi& E) {
    const int wid = __builtin_amdgcn_readfirstlane(tid >> 6), lane = tid & 63, wr = wid >> 2, wc = wid & 3, fr = lane & 15, fq = lane >> 4;
    unsigned voffA[2], voffB[2];
#pragma unroll
    for (int i = 0; i < 2; ++i) { int R, C; stage_rc(tid * 16 + i * 8192, R, C); const int Rb = Epi::PERM ? ((R & ~31) + perm32(R & 31)) : R;
        const int Ra = Epi::APERM ? ((R & ~63) + 4 * (R & 15) + ((R >> 4) & 3)) : R;
        voffA[i] = (unsigned)Ra * lda + (unsigned)C * 2u; voffB[i] = (unsigned)Rb * ldb + (unsigned)C * 2u; }
    const size_t kstep = (size_t)(BK * 2);
    const unsigned ldsw = (unsigned)wid * 1024u;
    const int aoff = lds_byte(wr * 64 + fr, fq * 8), boff = lds_byte(wc * 32 + fr, fq * 8);
#define PG8_SA(b, h) (((b) * 2 + (h)) * HTB)
#define PG8_SB(b, h) ((4 + (b) * 2 + (h)) * HTB)
#define PG8_STAGE(bufoff, gbase, voff) do { _Pragma("unroll") for (int _i = 0; _i < 2; ++_i) \
        __builtin_amdgcn_global_load_lds((const unsigned*)((const char*)(gbase) + (voff)[_i]), (LAS unsigned*)(lds + (bufoff) + ldsw + _i * 8192), 16, 0, 0); } while (0)
#define PG8_LDA(dst, b, h) do { _Pragma("unroll") for (int m = 0; m < 4; ++m) _Pragma("unroll") for (int k = 0; k < 2; ++k) dst[m][k] = *(const LAS bf16x8*)(lds + PG8_SA(b, h) + aoff + m * 2048 + k * 1024); } while (0)
#define PG8_LDB(dst, b, h) do { _Pragma("unroll") for (int n = 0; n < 2; ++n) _Pragma("unroll") for (int k = 0; k < 2; ++k) dst[n][k] = *(const LAS bf16x8*)(lds + PG8_SB(b, h) + boff + n * 2048 + k * 1024); } while (0)
#define PG8_MMA(ai, bj, At, Bt) do { __builtin_amdgcn_s_setprio(1); _Pragma("unroll") for (int m = 0; m < 4; ++m) _Pragma("unroll") for (int n = 0; n < 2; ++n) _Pragma("unroll") for (int k = 0; k < 2; ++k) \
        acc[ai][bj][m][n] = __builtin_amdgcn_mfma_f32_16x16x32_bf16(Bt[n][k], At[m][k], acc[ai][bj][m][n], 0, 0, 0); __builtin_amdgcn_s_setprio(0); } while (0)
#ifdef DBG_DRAIN
#define PG8_WAIT_V(n) asm volatile("s_waitcnt vmcnt(0)" ::: "memory")
#else
#define PG8_WAIT_V(n) asm volatile("s_waitcnt vmcnt(" #n ")" ::: "memory")
#endif
#define PG8_WAIT_L(n) asm volatile("s_waitcnt lgkmcnt(" #n ")" ::: "memory")
#define PG8_BAR __builtin_amdgcn_s_barrier()
#define PG8_SCHED __builtin_amdgcn_sched_barrier(0)
    Unit cur, nxt; int ui = 0;
    if (!S.next(0, cur)) return;
    f32x4 acc[2][2][4][2];
#pragma unroll
    for (int a = 0; a < 2; ++a)
#pragma unroll
        for (int b = 0; b < 2; ++b)
#pragma unroll
            for (int m = 0; m < 4; ++m)
#pragma unroll
                for (int n = 0; n < 2; ++n) acc[a][b][m][n] = (f32x4){0.f, 0.f, 0.f, 0.f};
    bf16x8 At[4][2], B0[2][2], B1[2][2];
    const char* cA = cur.A; const char* cB = cur.B;
    PG8_STAGE(PG8_SB(0, 0), cB, voffB); PG8_STAGE(PG8_SB(0, 1), cB + hstepB, voffB); PG8_STAGE(PG8_SA(0, 0), cA, voffA); PG8_STAGE(PG8_SA(0, 1), cA + hstepA, voffA);
    if (wr == 1) PG8_BAR;
    PG8_WAIT_V(2); PG8_BAR;
    PG8_STAGE(PG8_SB(1, 0), cB + kstep, voffB); PG8_STAGE(PG8_SA(1, 0), cA + kstep, voffA); PG8_STAGE(PG8_SB(1, 1), cB + hstepB + kstep, voffB);
    PG8_WAIT_V(6); PG8_BAR;
    for (;;) {
        const bool has_next = S.next(ui + 1, nxt);
        const char* nA = has_next ? nxt.A : cA; const char* nB = has_next ? nxt.B : cB;
        if constexpr (Epi::PRE) { cur.dst = (ui & 1) * 4096; E.pre(cur, tid); }
        int nt = cur.nt; asm volatile("" : "+s"(nt));
        for (int t = 0; t < nt; t += 2) {
            const bool last = (t == nt - 2);
            const char* a1 = cA + (size_t)(t + 1) * kstep;
            const char* a2 = last ? nA : cA + (size_t)(t + 2) * kstep; const char* b2 = last ? nB : cB + (size_t)(t + 2) * kstep;
            const char* a3 = a2 + kstep; const char* b3 = b2 + kstep;
            PG8_LDB(B0, 0, 0); PG8_LDB(B1, 0, 1); PG8_SCHED; PG8_LDA(At, 0, 0); PG8_STAGE(PG8_SA(1, 1), a1 + hstepA, voffA);
            PG8_WAIT_V(8); PG8_WAIT_L(0); PG8_BAR; PG8_MMA(0, 0, At, B0); PG8_MMA(0, 1, At, B1); PG8_BAR; PG8_SCHED;
            PG8_LDA(At, 0, 1); PG8_STAGE(PG8_SB(0, 0), b2, voffB); PG8_STAGE(PG8_SB(0, 1), b2 + hstepB, voffB); PG8_STAGE(PG8_SA(0, 0), a2, voffA);
            PG8_WAIT_V(8); PG8_WAIT_L(0); PG8_BAR; PG8_MMA(1, 0, At, B0); PG8_MMA(1, 1, At, B1); PG8_BAR; PG8_SCHED;
            PG8_LDB(B0, 1, 0); PG8_LDB(B1, 1, 1); PG8_SCHED; PG8_LDA(At, 1, 0); PG8_STAGE(PG8_SA(0, 1), a2 + hstepA, voffA);
            PG8_WAIT_V(8); PG8_WAIT_L(0); PG8_BAR; PG8_MMA(0, 0, At, B0); PG8_MMA(0, 1, At, B1); PG8_BAR; PG8_SCHED;
            PG8_LDA(At, 1, 1); PG8_STAGE(PG8_SB(1, 0), b3, voffB); PG8_STAGE(PG8_SB(1, 1), b3 + hstepB, voffB); PG8_STAGE(PG8_SA(1, 0), a3, voffA);
            PG8_WAIT_V(8); PG8_WAIT_L(0); PG8_BAR; PG8_MMA(1, 0, At, B0); PG8_MMA(1, 1, At, B1); PG8_BAR; PG8_SCHED;
        }
        if (wr == 0) PG8_BAR;
        { int fr_ = fr, fq_ = fq, wr_ = wr, wc_ = wc; asm volatile("" : "+v"(fr_), "+v"(fq_), "+s"(wr_), "+s"(wc_)); E(acc, cur, wr_, wc_, fr_, fq_); }
        if (!has_next) break;
#pragma unroll
        for (int a = 0; a < 2; ++a)
#pragma unroll
            for (int b = 0; b < 2; ++b)
#pragma unroll
                for (int m = 0; m < 4; ++m)
#pragma unroll
                    for (int n = 0; n < 2; ++n) acc[a][b][m][n] = (f32x4){0.f, 0.f, 0.f, 0.f};
        cur = nxt; cA = nA; cB = nB; ++ui;
        if (wr == 1) PG8_BAR;
    }
    PG8_WAIT_V(0);
    PG8_BAR;
#undef PG8_SA
#undef PG8_SB
#undef PG8_STAGE
#undef PG8_LDA
#undef PG8_LDB
#undef PG8_MMA
#undef PG8_WAIT_V
#undef PG8_WAIT_L
#undef PG8_BAR
#undef PG8_SCHED
}
}
using pg8::Unit;
typedef f32x4 Acc[2][2][4][2];

__device__ __forceinline__ u32x4 pack8(const f32x4 v0, const f32x4 v1) { u32x4 w; w.x = cvt_pk_bf16(v0[0], v0[1]); w.y = cvt_pk_bf16(v0[2], v0[3]); w.z = cvt_pk_bf16(v1[0], v1[1]); w.w = cvt_pk_bf16(v1[2], v1[3]); return w; }

__device__ __forceinline__ size_t gate_frag_off(int pm, int gct, int ai, int m, int bj, int wave, int lane) { return ((size_t)(pm * 32 + gct) << 16) + (size_t)(((((ai * 4 + m) * 2 + bj) * 8 + wave) * 64 + lane) * 8); }
struct EpiG1 {
    static constexpr bool PERM = true, PRE = false, APERM = false;
    bf16_t* P; bf16_t* PT; bf16_t* GATES; const float* bgate; const float* ropeC; const float* ropeS; const float* ropeCT; const float* ropeST;
    __device__ __forceinline__ void operator()(const Acc& acc, const Unit& u, int wr, int wc, int fr, int fq) const {
        const int ct0 = wc * 32 + 8 * fq;
        if (u.kind == 0) {
#pragma unroll
            for (int ai = 0; ai < 2; ++ai)
#pragma unroll
                for (int m = 0; m < 4; ++m) { bf16_t* rowp = P + (size_t)(u.r0 + ai * 128 + wr * 64 + m * 16 + fr) * INW + u.dst + ct0;
#pragma unroll
                    for (int bj = 0; bj < 2; ++bj) *(u32x4*)(rowp + bj * 128) = pack8(acc[ai][bj][m][0], acc[ai][bj][m][1]); }
        } else if (u.kind == 2) {
            f32x4 bv[2][2];
#pragma unroll
            for (int bj = 0; bj < 2; ++bj) { bv[bj][0] = *(const f32x4*)(bgate + u.dst + ct0 + bj * 128) * NLOG2E; bv[bj][1] = *(const f32x4*)(bgate + u.dst + ct0 + bj * 128 + 4) * NLOG2E; }
            SCHED_FENCE();
#pragma unroll
            for (int bj = 0; bj < 2; ++bj)
#pragma unroll
                for (int ai = 0; ai < 2; ++ai)
#pragma unroll
                    for (int m = 0; m < 4; ++m) { bf16_t* rowp = GATES + gate_frag_off(u.r0 >> 8, u.dst >> 8, ai, m, bj, wr * 4 + wc, fq * 16 + fr);
                        __builtin_nontemporal_store(pack8(acc[ai][bj][m][0] * NLOG2E + bv[bj][0], acc[ai][bj][m][1] * NLOG2E + bv[bj][1]), (u32x4*)(rowp)); }
        } else if (u.kind == 1) {
            const int s = seq_of_row(u.r0), pos0 = u.r0 - seq_start(s);
            const float sc = (u.c0 != 0) ? 0.08838834764831845f : 1.0f;
            const int hl = wc >> 1, jd0 = 32 * (wc & 1) + 8 * fq;
#pragma unroll
            for (int ai = 0; ai < 2; ++ai) { f32x4 cv[4][2], sv[4][2];
#pragma unroll
                for (int m = 0; m < 4; ++m) { const int pos = pos0 + ai * 128 + wr * 64 + m * 16 + fr;
#pragma unroll
                    for (int n = 0; n < 2; ++n) { cv[m][n] = *(const f32x4*)(ropeC + (size_t)pos * 64 + jd0 + 4 * n); sv[m][n] = *(const f32x4*)(ropeS + (size_t)pos * 64 + jd0 + 4 * n); } }
                SCHED_FENCE();
#pragma unroll
                for (int m = 0; m < 4; ++m) { const int rt = ai * 128 + wr * 64 + m * 16 + fr; bf16_t* rowp = P + (size_t)(u.r0 + rt) * INW + u.dst + hl * 128 + jd0;
#pragma unroll
                    for (int n = 0; n < 2; ++n) { const f32x4 x1 = acc[ai][0][m][n], x2 = acc[ai][1][m][n]; const f32x4 o1 = (x1 * cv[m][n] - x2 * sv[m][n]) * sc, o2 = (x1 * sv[m][n] + x2 * cv[m][n]) * sc;
                        u32x2 w1, w2; w1.x = cvt_pk_bf16(o1[0], o1[1]); w1.y = cvt_pk_bf16(o1[2], o1[3]); w2.x = cvt_pk_bf16(o2[0], o2[1]); w2.y = cvt_pk_bf16(o2[2], o2[3]);
                        *(u32x2*)(rowp + 4 * n) = w1; *(u32x2*)(rowp + 64 + 4 * n) = w2; } }
                SCHED_FENCE(); }
        } else {
#pragma unroll
            for (int ai = 0; ai < 2; ++ai)
#pragma unroll
                for (int m = 0; m < 4; ++m) { bf16_t* rowp = PT + (size_t)(u.dst + ai * 128 + wr * 64 + m * 16 + fr) * MTOK + u.c0 + ct0;
#pragma unroll
                    for (int bj = 0; bj < 2; ++bj) *(u32x4*)(rowp + bj * 128) = pack8(acc[ai][bj][m][0], acc[ai][bj][m][1]); }
        }
    }
};
struct SchedG1 {
    int G, c; const char* H; const char* W1T;
    __device__ __forceinline__ bool next(int i, Unit& u) const {
        int pm, pn; if (!pg8::tile_order(i, G, c, 96, 50, pm, pn)) return false;
        const size_t rowb = 4096;
        u.nt = 32; u.r0 = pm * 256; u.c0 = 0;
        if (pn < 46) {
            u.A = H + (size_t)pm * 256 * rowb;
            if (pn < 14) { u.B = W1T + (size_t)pn * 256 * rowb;
                if (pn >= 4 && pn < 8) { u.kind = 1; u.c0 = (pn >= 6) ? 1 : 0; u.dst = (pn < 6) ? 1024 + (pn - 4) * 256 : 1536 + (pn - 6) * 256; }
                else { u.kind = 0; u.dst = pn < 4 ? pn * 256 : (pn < 10 ? 2560 + (pn - 8) * 256 : (pn < 12 ? 3072 + (pn - 10) * 256 : 3584 + (pn - 12) * 256)); } }
            else { u.B = W1T + (size_t)(4608 + (pn - 14) * 256) * rowb; u.kind = 2; u.dst = (pn - 14) * 256; }
        } else {
            u.B = H + (size_t)pm * 256 * rowb; u.c0 = pm * 256;
            u.A = W1T + (size_t)(3584 + (pn - 46) * 256) * rowb; u.kind = 3; u.dst = 512 + (pn - 46) * 256;
        }
        return true;
    }
};

__device__ __forceinline__ size_t yt_seq_off(int s) { return s < 2 ? (size_t)s * 512 * 64 * 256 : (size_t)2 * 512 * 64 * 256 + (size_t)(s - 2) * 512 * 32 * 256; }
struct EpiCDFT {
    static constexpr bool PERM = false, PRE = false, APERM = false;
    bf16_t* YT;
    __device__ __forceinline__ void operator()(const Acc& acc, const Unit& u, int wr, int wc, int fr, int fq) const {
        const int s = u.kind, N2 = seq_len(s) >> 7; bf16_t* yt = YT + yt_seq_off(s);
#pragma unroll
        for (int m = 0; m < 4; ++m) { const int col = u.dst * 128 + 64 * wr + 16 * m + fr;
#pragma unroll
            for (int bj = 0; bj < 2; ++bj) { bf16_t* rowp = yt + ((size_t)(col * N2 + u.c0 + bj) * 2) * 128 + 32 * wc + 4 * fq;
#pragma unroll
                for (int n = 0; n < 2; ++n) { const f32x4 cv = acc[0][bj][m][n], sv = acc[1][bj][m][n];
                    u32x2 w0, w1; w0.x = cvt_pk_bf16(cv[0], cv[1]); w0.y = cvt_pk_bf16(cv[2], cv[3]); w1.x = cvt_pk_bf16(sv[0], sv[1]); w1.y = cvt_pk_bf16(sv[2], sv[3]);
                    *(u32x2*)(rowp + 16 * n) = w0; *(u32x2*)(rowp + 128 + 16 * n) = w1; } } }
    }
};
struct SchedCDFT {
    int G, c; const char* D2; const char* P; int lng;
    __device__ __forceinline__ bool next(int i, Unit& u) const {
        const int L = i * G + c; int s, bp, g;
        if (lng) { if (L >= 256) return false; s = L >> 7; bp = (L & 127) >> 2; g = L & 3; }
        else { if (L >= 128) return false; s = 2 + (L >> 6); bp = (L & 63) >> 2; g = L & 3; }
        u.A = D2; u.B = P + ((size_t)(seq_start(s) + 2 * bp) * INW + 512 + g * 128) * 2; u.nt = 2; u.kind = s; u.dst = g; u.c0 = 2 * bp; u.r0 = 0; return true;
    }
};
struct EpiF1 {
    static constexpr bool PERM = true, PRE = false, APERM = false;
    bf16_t* ZT; const float* twl; const float* tws;
    __device__ __forceinline__ void operator()(const Acc& acc, const Unit& u, int wr, int wc, int fr, int fq) const {
        const int s = u.kind; const bool lng = s < 2; const int N2 = lng ? 64 : 32, sh = lng ? 6 : 5; const float* tc = lng ? twl : tws; const float* ts = tc + 128 * N2;
        bf16_t* zt = ZT + (size_t)s * 65536 * 128;
#pragma unroll
        for (int mp = 0; mp < 2; ++mp) { f32x4 tcv[2][2][2], tsv[2][2][2];
#pragma unroll
            for (int mm = 0; mm < 2; ++mm) { const int c = 64 * wr + 16 * (2 * mp + mm) + fr;
#pragma unroll
                for (int bj = 0; bj < 2; ++bj) { const int b = (u.c0 + 128 * bj + 32 * wc + 8 * fq) & (N2 - 1);
                    tcv[mm][bj][0] = *(const f32x4*)(tc + c * N2 + b); tcv[mm][bj][1] = *(const f32x4*)(tc + c * N2 + b + 4); tsv[mm][bj][0] = *(const f32x4*)(ts + c * N2 + b); tsv[mm][bj][1] = *(const f32x4*)(ts + c * N2 + b + 4); } }
            SCHED_FENCE();
#pragma unroll
            for (int mm = 0; mm < 2; ++mm) { const int m = 2 * mp + mm, c = 64 * wr + 16 * m + fr;
#pragma unroll
                for (int bj = 0; bj < 2; ++bj) { const int n0 = u.c0 + 128 * bj + 32 * wc + 8 * fq, col = n0 >> sh, b = n0 & (N2 - 1);
                    bf16_t* rowp = zt + ((size_t)c * 512 + col) * 128;
                    const f32x4 c0 = tcv[mm][bj][0], c1 = tcv[mm][bj][1], s0 = tsv[mm][bj][0], s1 = tsv[mm][bj][1];
                    const f32x4 zr0 = acc[0][bj][m][0], zr1 = acc[0][bj][m][1], zi0 = acc[1][bj][m][0], zi1 = acc[1][bj][m][1];
                    *(u32x4*)(rowp + b) = pack8(zr0 * c0 + zi0 * s0, zr1 * c1 + zi1 * s1);
                    *(u32x4*)(rowp + N2 + b) = pack8(zi0 * c0 - zr0 * s0, zi1 * c1 - zr1 * s1);
                    if (!lng) { const u32x4 z = (u32x4){0u, 0u, 0u, 0u}; *(u32x4*)(rowp + 64 + b) = z; *(u32x4*)(rowp + 96 + b) = z; } } }
            SCHED_FENCE(); }
    }
};
struct SchedF1 {
    int G, c; const char* A1; const char* YT;
    __device__ __forceinline__ bool next(int i, Unit& u) const {
        const int L = i * G + c; if (L >= 384) return false; int s, t;
        if (L < 256) { s = L >> 7; t = L & 127; } else { s = 2 + ((L - 256) >> 6); t = (L - 256) & 63; }
        u.A = A1; u.B = YT + yt_seq_off(s) * 2 + (size_t)t * 256 * 512; u.nt = 4; u.kind = s; u.c0 = t * 256; u.r0 = 0; u.dst = 0; return true;
    }
};
struct EpiF2 {
    static constexpr bool PERM = true, PRE = false, APERM = false;
    bf16_t* BR;
    __device__ __forceinline__ void operator()(const Acc& acc, const Unit& u, int wr, int wc, int fr, int fq) const {
        const int s = u.kind; const bool lng = s < 2; const float sc = lng ? 9.765625e-4f : 1.3810679320049757e-3f;
        if (wr != 0) return;
        const int st = seq_start(s);
#pragma unroll
        for (int m = 0; m < 4; ++m) { if (!lng && m >= 2) break; const int d = 16 * m + fr;
#pragma unroll
            for (int bj = 0; bj < 2; ++bj) { const int n0 = u.c0 + 128 * bj + 32 * wc + 8 * fq, c = n0 >> 9, col = n0 & 511;
                *(u32x4*)(BR + (size_t)(st + c + 128 * d) * D + 512 + col) = pack8(acc[0][bj][m][0] * sc, acc[0][bj][m][1] * sc); } }
    }
};
struct SchedF2 {
    int G, c; const char* A2L; const char* A2S; const char* ZT;
    __device__ __forceinline__ bool next(int i, Unit& u) const {
        const int L = i * G + c; if (L >= 1024) return false; const int s = L >> 8, t = L & 255;
        u.A = s < 2 ? A2L : A2S; u.B = ZT + (size_t)s * 65536 * 256 + (size_t)t * 256 * 256; u.nt = 2; u.kind = s; u.c0 = t * 256; u.r0 = 0; u.dst = 0; return true;
    }
};
__device__ __forceinline__ u32x4 ldg16_raw(const void* p) { u32x4 v; asm volatile("global_load_dwordx4 %0, %1, off" : "=v"(v) : "v"(p) : "memory"); return v; }
__device__ __forceinline__ u32x4 ldg16_so(const void* base, unsigned off) { u32x4 v; asm volatile("global_load_dwordx4 %0, %1, %2" : "=v"(v) : "v"(off), "s"(base) : "memory"); return v; }
__device__ __forceinline__ u32x4 ldg16_so_nt(const void* base, unsigned off) { u32x4 v; asm volatile("global_load_dwordx4 %0, %1, %2 nt" : "=v"(v) : "v"(off), "s"(base) : "memory"); return v; }
__device__ __forceinline__ u32x4 ldg16_raw256(const void* p) { u32x4 v; asm volatile("global_load_dwordx4 %0, %1, off offset:256" : "=v"(v) : "v"(p) : "memory"); return v; }
#define VM_WAIT(n) asm volatile("s_waitcnt vmcnt(" #n ")" ::: "memory")
#define VM_USE8(a, b, c, d, e, f, g, h) asm volatile("" : "+v"(a), "+v"(b), "+v"(c), "+v"(d), "+v"(e), "+v"(f), "+v"(g), "+v"(h))
struct EpiMerge {
    static constexpr bool PERM = true, PRE = false, APERM = false;
    bf16_t* MERGED; const bf16_t* GATES; const bf16_t* ZERO;
    __device__ __forceinline__ void ld(u32x4 (&gv)[2][2], u32x4 (&ov)[2][2], const Unit& u, int step, unsigned gvo, unsigned ovo) const {
        const int b = u.kind, ai = step >> 1;
        const bf16_t* gt = GATES + ((size_t)((u.r0 >> 8) * 32 + b * 8 + (u.c0 >> 8)) << 16);
        const bf16_t* ot = (b != 0) ? MERGED + (size_t)u.r0 * D + u.c0 : ZERO;
#pragma unroll
        for (int mm = 0; mm < 2; ++mm) { const int m = (step & 1) * 2 + mm;
            gv[mm][0] = ldg16_so_nt(gt + (((ai * 4 + m) * 2 + 0) * 8) * 512, gvo); gv[mm][1] = ldg16_so_nt(gt + (((ai * 4 + m) * 2 + 1) * 8) * 512, gvo);
            const bf16_t* orow = (b != 0) ? ot + (size_t)(ai * 128 + m * 16) * D : ot;
            ov[mm][0] = ldg16_so(orow, ovo); ov[mm][1] = ldg16_so(orow + 128, ovo); }
    }
    __device__ __forceinline__ void operator()(const Acc& acc, const Unit& u, int wr, int wc, int fr, int fq) const {
        const int ct0 = wc * 32 + 8 * fq;
        u32x4 gv[2][2][2], ov[2][2][2];
        const unsigned gvo = (unsigned)(((wr * 4 + wc) * 64 + fq * 16 + fr) * 16), ovo = (u.kind != 0) ? (unsigned)(((wr * 64 + fr) * D + ct0) * 2) : (unsigned)(ct0 * 2);
        ld(gv[0], ov[0], u, 0, gvo, ovo); ld(gv[1], ov[1], u, 1, gvo, ovo);
        SCHED_FENCE();
#pragma unroll
        for (int step = 0; step < 4; ++step) { const int ai = step >> 1, st = step & 1;
            if (step == 0 || step == 3) VM_WAIT(8); else if (step == 1) VM_WAIT(12); else VM_WAIT(16);
            VM_USE8(gv[st][0][0], gv[st][0][1], gv[st][1][0], gv[st][1][1], ov[st][0][0], ov[st][0][1], ov[st][1][0], ov[st][1][1]);
            SCHED_FENCE();
            u32x4 res[2][2];
#pragma unroll
            for (int mm = 0; mm < 2; ++mm) { const int m = st * 2 + mm;
#pragma unroll
                for (int bj = 0; bj < 2; ++bj) { const u32x4 g = gv[st][mm][bj], o = ov[st][mm][bj]; f32x4 v0 = acc[ai][bj][m][0], v1 = acc[ai][bj][m][1];
                    v0[0] = v0[0] * sig2_(bflo(g.x)) + bflo(o.x); v0[1] = v0[1] * sig2_(bfhi(g.x)) + bfhi(o.x); v0[2] = v0[2] * sig2_(bflo(g.y)) + bflo(o.y); v0[3] = v0[3] * sig2_(bfhi(g.y)) + bfhi(o.y);
                    v1[0] = v1[0] * sig2_(bflo(g.z)) + bflo(o.z); v1[1] = v1[1] * sig2_(bfhi(g.z)) + bfhi(o.z); v1[2] = v1[2] * sig2_(bflo(g.w)) + bflo(o.w); v1[3] = v1[3] * sig2_(bfhi(g.w)) + bfhi(o.w);
                    res[mm][bj] = pack8(v0, v1); } }
            SCHED_FENCE();
            if (step < 2) { ld(gv[st], ov[st], u, step + 2, gvo, ovo); SCHED_FENCE(); }
#pragma unroll
            for (int mm = 0; mm < 2; ++mm) { bf16_t* rowp = MERGED + (size_t)(u.r0 + ai * 128 + wr * 64 + (st * 2 + mm) * 16 + fr) * D + u.c0 + ct0;
#pragma unroll
                for (int bj = 0; bj < 2; ++bj) *(u32x4*)(rowp + bj * 128) = res[mm][bj]; }
            SCHED_FENCE(); }
    }
};
struct SchedMerge {
    int G, c; const char* BR; const char* WBRT;
    __device__ __forceinline__ bool next(int i, Unit& u) const {
        int pm, pn; if (!pg8::tile_order(i >> 2, G, c, 96, 8, pm, pn)) return false; const int b = i & 3;
        u.A = BR + (size_t)pm * 256 * 4096 + (size_t)b * 1024; u.B = WBRT + (size_t)b * (2048 * 1024) + (size_t)pn * 256 * 1024; u.nt = 8; u.kind = b; u.r0 = pm * 256; u.c0 = pn * 256; u.dst = 0; return true;
    }
};
template <int OFF> __device__ __forceinline__ f32x4 ldg16f_raw(const void* p) { f32x4 v; asm volatile("global_load_dwordx4 %0, %1, off offset:%2" : "=v"(v) : "v"(p), "n"(OFF) : "memory"); return v; }
#define VM_USE4(a, b, c, d) asm volatile("" : "+v"(a), "+v"(b), "+v"(c), "+v"(d))
struct EpiRes {
    static constexpr bool PERM = true, PRE = false, APERM = false;
    bf16_t* xb; const float* gate;
    __device__ __forceinline__ void ld(u32x4 (&xv)[2][2], const Unit& u, int step, int wr, int fr, int ct0) const {
#pragma unroll
        for (int mm = 0; mm < 2; ++mm) { const bf16_t* p = xb + (size_t)(u.r0 + (step >> 1) * 128 + wr * 64 + ((step & 1) * 2 + mm) * 16 + fr) * D + u.c0 + ct0;
            xv[mm][0] = ldg16_raw(p); xv[mm][1] = ldg16_raw256(p); }
    }
    __device__ __forceinline__ void operator()(const Acc& acc, const Unit& u, int wr, int wc, int fr, int fq) const {
        const int s = seq_of_row(u.r0); const int ct0 = wc * 32 + 8 * fq; const float* gv = gate + (size_t)s * 12288 + u.c0 + ct0;
        f32x4 g8[2][2]; u32x4 xv[2][2][2];
        g8[0][0] = ldg16f_raw<0>(gv); g8[0][1] = ldg16f_raw<16>(gv); g8[1][0] = ldg16f_raw<512>(gv); g8[1][1] = ldg16f_raw<528>(gv);
        ld(xv[0], u, 0, wr, fr, ct0); ld(xv[1], u, 1, wr, fr, ct0);
        SCHED_FENCE();
#pragma unroll
        for (int step = 0; step < 4; ++step) { const int ai = step >> 1, st = step & 1;
            if (step == 0) VM_WAIT(4); else if (step == 2) VM_WAIT(12); else VM_WAIT(8);
            if (step == 0) VM_USE4(g8[0][0], g8[0][1], g8[1][0], g8[1][1]);
            VM_USE4(xv[st][0][0], xv[st][0][1], xv[st][1][0], xv[st][1][1]);
            SCHED_FENCE();
            u32x4 res[2][2];
#pragma unroll
            for (int mm = 0; mm < 2; ++mm)
#pragma unroll
                for (int bj = 0; bj < 2; ++bj) { const u32x4 o = xv[st][mm][bj]; const int m = st * 2 + mm;
                    const f32x4 x0 = {bflo(o.x), bfhi(o.x), bflo(o.y), bfhi(o.y)}, x1 = {bflo(o.z), bfhi(o.z), bflo(o.w), bfhi(o.w)};
                    res[mm][bj] = pack8(x0 + g8[bj][0] * acc[ai][bj][m][0], x1 + g8[bj][1] * acc[ai][bj][m][1]); }
            SCHED_FENCE();
            if (step < 2) { ld(xv[st], u, step + 2, wr, fr, ct0); SCHED_FENCE(); }
#pragma unroll
            for (int mm = 0; mm < 2; ++mm) { bf16_t* rowp = xb + (size_t)(u.r0 + ai * 128 + wr * 64 + (st * 2 + mm) * 16 + fr) * D + u.c0 + ct0;
#pragma unroll
                for (int bj = 0; bj < 2; ++bj) *(u32x4*)(rowp + bj * 128) = res[mm][bj]; }
            SCHED_FENCE(); }
    }
};
struct SchedPlain {
    int G, c; const char* A; const char* B; int nN, nt; size_t rowb;
    __device__ __forceinline__ bool next(int i, Unit& u) const {
        int pm, pn; if (!pg8::tile_order(i, G, c, 96, nN, pm, pn)) return false;
        u.A = A + (size_t)pm * 256 * rowb; u.B = B + (size_t)pn * 256 * rowb; u.nt = nt; u.kind = 0; u.r0 = pm * 256; u.c0 = pn * 256; u.dst = 0; return true;
    }
};
struct EpiUpConv {
    static constexpr bool PERM = true, PRE = true, APERM = true;
    bf16_t* ACT; bf16_t* YB; const float* cw; const float* cb; LAS unsigned char* scr;
    __device__ __forceinline__ void pre(const Unit& u, int tid) const {
        const int kind = tid >> 7, ch = (u.c0 >> 1) + (tid & 127);
        const float* s0 = (kind < 3) ? cw + (size_t)kind * NUP + ch : cb + ch;
        LAS unsigned char* d = scr + u.dst + __builtin_amdgcn_readfirstlane(tid >> 6) * 256;
        __builtin_amdgcn_global_load_lds((const unsigned*)s0, (LAS unsigned*)d, 4, 0, 0);
        __builtin_amdgcn_global_load_lds((const unsigned*)(s0 + DFF), (LAS unsigned*)(d + 2048), 4, 0, 0);
    }
    __device__ __forceinline__ void operator()(const Acc& acc, const Unit& u, int wr, int wc, int fr, int fq) const {
        const int chl0 = 32 * wc + 8 * fq, chan0 = (u.c0 >> 1) + chl0;
        const LAS unsigned char* wl = scr + u.dst;
#pragma unroll
        for (int ai = 0; ai < 2; ++ai) { const int row0 = u.r0 + ai * 128 + wr * 64 + 4 * fr; unsigned w0[4][2];
#pragma unroll
            for (int n = 0; n < 2; ++n) { unsigned wv[4];
#pragma unroll
                for (int ep = 0; ep < 2; ++ep) { const int e0 = 2 * ep; const LAS unsigned char* wp = wl + (chl0 + 4 * n + e0) * 4;
                    const f32x2 a0p = *(const LAS f32x2*)(wp), a1p = *(const LAS f32x2*)(wp + 512), a2p = *(const LAS f32x2*)(wp + 1024), abp = *(const LAS f32x2*)(wp + 1536);
                    const f32x2 b0p = *(const LAS f32x2*)(wp + 2048), b1p = *(const LAS f32x2*)(wp + 2560), b2p = *(const LAS f32x2*)(wp + 3072), bbp = *(const LAS f32x2*)(wp + 3584);
                    f32x2 y[2][4];
#pragma unroll
                    for (int bj = 0; bj < 2; ++bj)
#pragma unroll
                        for (int m = 0; m < 4; ++m) y[bj][m] = (f32x2){acc[ai][bj][m][n][e0], acc[ai][bj][m][n][e0 + 1]};
                    const f32x2 pa0 = {dpp_ror1(y[0][3].x), dpp_ror1(y[0][3].y)}, na3 = {dpp_ror15(y[0][0].x), dpp_ror15(y[0][0].y)};
                    const f32x2 pb0 = {dpp_ror1(y[1][3].x), dpp_ror1(y[1][3].y)}, nb3 = {dpp_ror15(y[1][0].x), dpp_ror15(y[1][0].y)};
                    f32x2 ua[4], ub[4], ex[4];
#pragma unroll
                    for (int m = 0; m < 4; ++m) {
                        const f32x2 pa = m > 0 ? y[0][m > 0 ? m - 1 : 0] : pa0, na = m < 3 ? y[0][m < 3 ? m + 1 : 3] : na3;
                        const f32x2 pb = m > 0 ? y[1][m > 0 ? m - 1 : 0] : pb0, nb = m < 3 ? y[1][m < 3 ? m + 1 : 3] : nb3;
                        ua[m] = a0p * pa + (a1p * y[0][m] + (a2p * na + abp)); ub[m] = b0p * pb + (b1p * y[1][m] + (b2p * nb + bbp));
                        const f32x2 q = ua[m] * (ua[m] * ua[m] * 0.10294324f + 2.3022082f);
                        ex[m].x = __builtin_amdgcn_exp2f(q.x); ex[m].y = __builtin_amdgcn_exp2f(q.y); }
                    SCHED_FENCE();
#pragma unroll
                    for (int m = 0; m < 4; ++m) { ex[m] = ex[m] + 1.0f; ex[m].x = fast_rcp(ex[m].x); ex[m].y = fast_rcp(ex[m].y); }
                    SCHED_FENCE();
#pragma unroll
                    for (int m = 0; m < 4; ++m) { const f32x2 o = (ua[m] - ua[m] * ex[m]) * ub[m];
                        const unsigned wn = cvt_pk_bf16(o.x, o.y);
                        if (ep == 0) wv[m] = wn;
                        else if (n == 0) { w0[m][0] = wv[m]; w0[m][1] = wn; }
                        else { u32x4 w; w.x = w0[m][0]; w.y = w0[m][1]; w.z = wv[m]; w.w = wn;
                            *(u32x4*)(ACT + (size_t)(row0 + m) * DFF + chan0) = w; } } } }
            SCHED_FENCE(); }
        if (fr == 0 || fr == 15) {
#pragma unroll
            for (int ai = 0; ai < 2; ++ai) { const int blk = (u.r0 + ai * 128 + wr * 64) >> 6;
#pragma unroll
                for (int j = 0; j < 2; ++j) { bf16_t* yp = YB + ((size_t)blk * 4 + (fr == 0 ? j : 2 + j)) * NUP + chan0;
#pragma unroll
                    for (int bj = 0; bj < 2; ++bj) { const f32x4 v0 = (fr == 0) ? acc[ai][bj][j][0] : acc[ai][bj][2 + j][0], v1 = (fr == 0) ? acc[ai][bj][j][1] : acc[ai][bj][2 + j][1];
                        *(u32x4*)(yp + bj * DFF) = pack8(v0, v1); } } } }
    }
};

struct Args { const float* in[23]; float* out; unsigned char* ws; int ph_lo, ph_hi; };
struct Frame {
    LAS unsigned char* lds; int tid, lane, wave, G, gw, NGW, bid;
    float* out; unsigned char* ws;
};
#define LDS_WAIT() asm volatile("s_waitcnt lgkmcnt(0)" ::: "memory")

__device__ __forceinline__ void transpose_item(const float* W, int K, int N, bf16_t* WT, int drow, int k0, int n0, LAS float* scr, int lane) {
    (void)scr; const int kq = lane >> 3, n4 = lane & 7;
    f32x4 tv[8];
#pragma unroll
    for (int i = 0; i < 8; ++i) tv[i] = __builtin_nontemporal_load((const f32x4*)(W + (size_t)(k0 + 8 * kq + i) * N + n0 + 4 * n4));
#pragma unroll
    for (int e = 0; e < 4; ++e) { u32x4 o; o.x = cvt_pk_bf16(tv[0][e], tv[1][e]); o.y = cvt_pk_bf16(tv[2][e], tv[3][e]); o.z = cvt_pk_bf16(tv[4][e], tv[5][e]); o.w = cvt_pk_bf16(tv[6][e], tv[7][e]);
        __builtin_nontemporal_store(o, (u32x4*)(WT + (size_t)(drow + 4 * n4 + e) * K + k0 + 8 * kq)); }
}
__device__ __forceinline__ int map_in(int n0) {
    if (n0 < 1024) return n0;
    if (n0 < 2048) { const int off = n0 - 1024, which = off >> 9, hh = (off & 511) >> 7, d = off & 127, half = d >> 6, jd = d & 63; return 1024 + which * 512 + (hh >> 1) * 256 + half * 128 + (hh & 1) * 64 + jd; }
    if (n0 < 2560) return 3584 + (n0 - 2048);
    if (n0 < 3072) return 2048 + (n0 - 2560);
    if (n0 < 3584) return 2560 + (n0 - 3072);
    if (n0 < 4096) return 3072 + (n0 - 3584);
    return n0;
}
constexpr int CV_IN = (D / 64) * (INW / 32), CV_G = (D / 64) * (NGATE / 32), CV_BR = (512 / 64) * (D / 32), CV_OUT = (D / 64) * (D / 32), CV_UP = (D / 64) * (NUP / 32), CV_DN = (DFF / 64) * (D / 32);
constexpr int CV_A = CV_IN + CV_G + 3 * CV_BR + CV_OUT, CV_N = CV_A + CV_UP + CV_DN;
constexpr int CV_QG1 = 5120, CV_QUP = 10240;
__device__ __forceinline__ void convert_span(Frame& F, int l, const float* w_in0, const float* w_gate0, const float* w_branch0, const float* w_out0, const float* w_up0, const float* w_down0, int lo1, int len1, int lo2, int len2, int w0, int nw) {
    const float* w_in = w_in0 + (size_t)l * D * INW; const float* w_gate = w_gate0 + (size_t)l * D * NGATE; const float* w_branch = w_branch0 + (size_t)l * 4 * 512 * D;
    const float* w_out = w_out0 + (size_t)l * D * D; const float* w_up = w_up0 + (size_t)l * D * NUP; const float* w_down = w_down0 + (size_t)l * DFF * D;
    bf16_t* W1T = (bf16_t*)(F.ws + WS_W1T); bf16_t* WBRT = (bf16_t*)(F.ws + WS_WBRT); bf16_t* WOUTT = (bf16_t*)(F.ws + WS_WOUTT); bf16_t* WUPT = (bf16_t*)(F.ws + WS_WUPT); bf16_t* WDNT = (bf16_t*)(F.ws + WS_WDNT);
    LAS float* scr = nullptr;
    for (int v = w0; v < len1 + len2; v += nw) {
        int r = v < len1 ? lo1 + v : lo2 + (v - len1);
        if (r < CV_IN) { const int nb = INW / 32, kb = r / nb, n0 = (r % nb) * 32; transpose_item(w_in, D, INW, W1T, map_in(n0), kb * 64, n0, scr, F.lane); continue; } r -= CV_IN;
        if (r < CV_G) { const int nb = NGATE / 32, kb = r / nb, n0 = (r % nb) * 32; transpose_item(w_gate, D, NGATE, W1T, 4608 + n0, kb * 64, n0, scr, F.lane); continue; } r -= CV_G;
        if (r < 3 * CV_BR) { const int b = 1 + r / CV_BR, rr = r % CV_BR, nb = D / 32, kb = rr / nb, n0 = (rr % nb) * 32; transpose_item(w_branch + (size_t)b * 512 * D, 512, D, WBRT + (size_t)b * D * 512, n0, kb * 64, n0, scr, F.lane); continue; } r -= 3 * CV_BR;
        if (r < CV_OUT) { const int nb = D / 32, kb = r / nb, n0 = (r % nb) * 32; transpose_item(w_out, D, D, WOUTT, n0, kb * 64, n0, scr, F.lane); continue; } r -= CV_OUT;
        if (r < CV_UP) { const int nb = NUP / 32, kb = r / nb, n0 = (r % nb) * 32; transpose_item(w_up, D, NUP, WUPT, (n0 < DFF ? (n0 >> 7) * 256 + (n0 & 127) : ((n0 - DFF) >> 7) * 256 + 128 + ((n0 - DFF) & 127)), kb * 64, n0, scr, F.lane); continue; } r -= CV_UP;
        { const int nb = D / 32, kb = r / nb, n0 = (r % nb) * 32; transpose_item(w_down, DFF, D, WDNT, n0, kb * 64, n0, scr, F.lane); }
    }
}
__device__ __forceinline__ void convert_tail(Frame& F, int l, const float* w_in0, const float* w_gate0, const float* w_branch0, const float* w_out0, const float* w_up0, const float* w_down0, int nwg, int lo, int len) {
    const int rem = nwg % F.G; if (rem != 0 && F.bid < rem) return;
    const int nidle = rem ? F.G - rem : F.G, rank = rem ? F.bid - rem : F.bid;
    convert_span(F, l, w_in0, w_gate0, w_branch0, w_out0, w_up0, w_down0, lo, len, 0, 0, rank * NWAVES + F.wave, nidle * NWAVES);
}
__device__ __forceinline__ void convert_weights(Frame& F, int l, const float* w_in0, const float* w_gate0, const float* w_branch0, const float* w_out0, const float* w_up0, const float* w_down0, const float* pool_w0, const float* pool_scale0, bool skip_up) {
    const int q = skip_up ? CV_QUP : 0;
    convert_span(F, l, w_in0, w_gate0, w_branch0, w_out0, w_up0, w_down0, q, CV_A - q, CV_A + CV_QG1, CV_N - CV_A - CV_QG1, F.gw, F.NGW);
    const float* w_branch = w_branch0 + (size_t)l * 4 * 512 * D; bf16_t* WBRT = (bf16_t*)(F.ws + WS_WBRT);
    const float* pw = pool_w0 + (size_t)l * 4 * 128 * 128; const float* ps = pool_scale0 + (size_t)l * 512;
    for (int item = F.bid; item < 256; item += F.G) {
        const int g = item >> 6, ns = (item >> 3) & 7, c0 = (item & 7) * 16 + 2 * F.wave, n0 = ns * 256 + 4 * F.lane;
        float cf[2][2];
#pragma unroll
        for (int j = 0; j < 2; ++j)
#pragma unroll
            for (int h = 0; h < 2; ++h) cf[j][h] = pw[((size_t)g * 128 + c0 + j) * 128 + 64 * h + F.lane] * ps[g * 128 + 64 * h + F.lane];
        const float* wb = w_branch + (size_t)(g * 128) * D + n0;
        f32x4 a0 = (f32x4){0.f, 0.f, 0.f, 0.f}, a1 = a0;
#pragma unroll
        for (int h = 0; h < 2; ++h)
#pragma unroll 16
            for (int el = 0; el < 64; ++el) { const f32x4 w = *(const f32x4*)(wb + (size_t)(64 * h + el) * D);
                const float k0 = __builtin_bit_cast(float, __builtin_amdgcn_readlane(__builtin_bit_cast(int, cf[0][h]), el)), k1 = __builtin_bit_cast(float, __builtin_amdgcn_readlane(__builtin_bit_cast(int, cf[1][h]), el));
                a0 += w * k0; a1 += w * k1; }
        const int k = g * 128 + c0;
#pragma unroll
        for (int j = 0; j < 4; ++j) *(unsigned*)(WBRT + (size_t)(n0 + j) * 512 + k) = cvt_pk_bf16(a0[j], a1[j]);
    }
}
__device__ __forceinline__ void prologue_tables(Frame& F) {
    float* rc = (float*)(F.ws + WS_ROPEC); float* rs = (float*)(F.ws + WS_ROPES);
    const int gt = F.bid * NTHREADS + F.tid, NGT = F.G * NTHREADS;
    for (int it = gt; it < 8192 * 64; it += NGT) { const int pos = it >> 6, j = it & 63;
        const float inv = __builtin_amdgcn_exp2f(-(float)j * (13.287712379549449f / 64.0f)); const float ang = (float)pos * inv;
        const double rev = (double)ang * 0.15915494309189535; const float fr = (float)(rev - floor(rev));
        const float cv = __builtin_amdgcn_cosf(fr), sv = __builtin_amdgcn_sinf(fr);
        rc[it] = cv; rs[it] = sv; }
    bf16_t* d2 = (bf16_t*)(F.ws + WS_D2);
    for (int it = gt; it < 256 * 128; it += NGT) { const int r = it >> 7, c = it & 127, s = r >> 7, kc = r & 127; const float fr = (float)((c * kc) & 127) * (1.0f / 128.0f);
        const float v = s ? __builtin_amdgcn_sinf(fr) : __builtin_amdgcn_cosf(fr); d2[it] = (bf16_t)(cvt_pk_bf16(v, 0.f) & 0xffffu); }
    bf16_t* a1 = (bf16_t*)(F.ws + WS_A1);
    for (int it = gt; it < 256 * 256; it += NGT) { const int r = it >> 8, k = it & 255, pp = r >> 7, c = r & 127, p = k >> 7, a = k & 127; const float fr = (float)((a * c) & 127) * (1.0f / 128.0f);
        const float cv = __builtin_amdgcn_cosf(fr), sv = __builtin_amdgcn_sinf(fr); const float v = (pp == 0) ? (p == 0 ? cv : -sv) : (p == 0 ? -sv : -cv); a1[it] = (bf16_t)(cvt_pk_bf16(v, 0.f) & 0xffffu); }
    bf16_t* a2l = (bf16_t*)(F.ws + WS_A2L); bf16_t* a2s = (bf16_t*)(F.ws + WS_A2S);
    for (int it = gt; it < 256 * 128; it += NGT) { const int d = it >> 7, k = it & 127;
        { const int p = k >> 6, b = k & 63; const float fr = (float)((b * d) & 63) * (1.0f / 64.0f); const float v = d < 64 ? (p ? __builtin_amdgcn_sinf(fr) : __builtin_amdgcn_cosf(fr)) : 0.f; a2l[it] = (bf16_t)(cvt_pk_bf16(v, 0.f) & 0xffffu); }
        { const int p = (k >> 5) & 1, b = k & 31; const float fr = (float)((b * d) & 31) * (1.0f / 32.0f); const float v = (d < 32 && k < 64) ? (p ? __builtin_amdgcn_sinf(fr) : __builtin_amdgcn_cosf(fr)) : 0.f; a2s[it] = (bf16_t)(cvt_pk_bf16(v, 0.f) & 0xffffu); } }
    float* twl = (float*)(F.ws + WS_TWL); float* tws = (float*)(F.ws + WS_TWS);
    for (int it = gt; it < 128 * 64; it += NGT) { const int c = it >> 6, b = it & 63; const float fr = (float)(b * c) * (1.0f / 8192.0f); twl[it] = __builtin_amdgcn_cosf(fr); twl[128 * 64 + it] = __builtin_amdgcn_sinf(fr); }
    for (int it = gt; it < 128 * 32; it += NGT) { const int c = it >> 5, b = it & 31; const float fr = (float)(b * c) * (1.0f / 4096.0f); tws[it] = __builtin_amdgcn_cosf(fr); tws[128 * 32 + it] = __builtin_amdgcn_sinf(fr); }
}
__device__ __forceinline__ void prologue_mod_partial(Frame& F, const float* c_prompt, const float* c_sample, const float* w_ada) {
    LAS float* sc = (LAS float*)F.lds;
    for (int i = F.tid; i < 4 * D; i += NTHREADS) { const int s = i >> 11, k = i & (D - 1); const float v = (s < 2 ? c_prompt : c_sample)[(s & 1) * D + k]; sc[i] = v * sigmoidf_(v); }
    __syncthreads();
    float* modp = (float*)(F.ws + WS_MODP);
    const int kq = F.tid >> 7, n4 = (F.tid & 127) * 4;
    for (int it = F.bid; it < DEPTH * 24 * 8; it += F.G) { const int l = it / 192, nb = (it % 192) >> 3, kp = it & 7; const int n = nb * 512 + n4, kbase = kp * 256 + kq * 64;
        const float* w = w_ada + ((size_t)l * D + kbase) * 12288 + n; f32x4 a0 = (f32x4){0.f, 0.f, 0.f, 0.f}, a1 = a0, a2 = a0, a3 = a0;
#pragma unroll 16
        for (int k = 0; k < 64; ++k) { const f32x4 wv = *(const f32x4*)(w + (size_t)k * 12288); const int kk = kbase + k; a0 += wv * sc[kk]; a1 += wv * sc[D + kk]; a2 += wv * sc[2 * D + kk]; a3 += wv * sc[3 * D + kk]; }
        float* o = modp + ((size_t)((kp * 4 + kq) * DEPTH + l) * 4) * 12288 + n; *(f32x4*)o = a0; *(f32x4*)(o + 12288) = a1; *(f32x4*)(o + 2 * 12288) = a2; *(f32x4*)(o + 3 * 12288) = a3; }
    __syncthreads();
}
__device__ __forceinline__ void prologue_mod_reduce(Frame& F, const float* b_ada) {
    const float* modp = (const float*)(F.ws + WS_MODP); float* mod = (float*)(F.ws + WS_MOD);
    for (int it = F.bid * NTHREADS + F.tid; it < DEPTH * 4 * 12288; it += F.G * NTHREADS) { const int n = it % 12288, l = it / (4 * 12288);
        float a = b_ada[(size_t)l * 12288 + n];
#pragma unroll
        for (int kp = 0; kp < 32; ++kp) a += modp[(size_t)kp * DEPTH * 4 * 12288 + it];
        mod[it] = a; }
}
__device__ __forceinline__ void unpack_row(const u32x4 (&w)[4], f32x4 (&v)[8]) {
#pragma unroll
    for (int j = 0; j < 4; ++j) { v[2 * j] = (f32x4){bflo(w[j].x), bfhi(w[j].x), bflo(w[j].y), bfhi(w[j].y)}; v[2 * j + 1] = (f32x4){bflo(w[j].z), bfhi(w[j].z), bflo(w[j].w), bfhi(w[j].w)}; }
}
__device__ __forceinline__ float sumsq8(const f32x4 (&v)[8]) { float s = 0.f;
#pragma unroll
    for (int j = 0; j < 8; ++j) s += (v[j].x * v[j].x + v[j].y * v[j].y) + (v[j].z * v[j].z + v[j].w * v[j].w);
    return s; }
template <bool SEED>
__device__ __forceinline__ void norm_phase(Frame& F, const float* xp, const float* xs, const float* g, const float* mod_l, int shift_off, int scale_off) {
    bf16_t* H = (bf16_t*)(F.ws + WS_H); bf16_t* XB = (bf16_t*)(F.ws + WS_XB);
    constexpr int RB = SEED ? 2 : 4;
    const int per = 4 * ((MTOK / 4 + F.NGW - 1) / F.NGW), m0 = F.gw * per;
    int cs = -1; f32x4 gs[8], hv[8];
#pragma unroll 1
    for (int i = 0; i < per; i += RB) {
        const int m = m0 + i; if (m >= MTOK) break; const int s = seq_of_row(m);
        if (s != cs) { cs = s; const float* sh = mod_l + (size_t)s * 12288 + shift_off; const float* scl = mod_l + (size_t)s * 12288 + scale_off;
            f32x4 gg[8], sv[8];
#pragma unroll
            for (int j = 0; j < 8; ++j) { const int c = SEED ? 4 * F.lane + 256 * j : 8 * F.lane + 512 * (j >> 1) + 4 * (j & 1); gg[j] = *(const f32x4*)(g + c); sv[j] = *(const f32x4*)(scl + c); hv[j] = *(const f32x4*)(sh + c); }
            SCHED_FENCE();
#pragma unroll
            for (int j = 0; j < 8; ++j) gs[j] = gg[j] * (sv[j] + 1.0f); }
        if (SEED) { f32x4 v0[8], v1[8];
            const float* x0 = (m < 16384 ? xp : xs) + (size_t)m * D; const float* x1 = x0 + D;
#pragma unroll
            for (int j = 0; j < 8; ++j) { v0[j] = *(const f32x4*)(x0 + 4 * F.lane + 256 * j); v1[j] = *(const f32x4*)(x1 + 4 * F.lane + 256 * j); }
#pragma unroll
            for (int j = 0; j < 8; ++j) { const int c = 4 * F.lane + 256 * j; u32x2 w0, w1; w0.x = cvt_pk_bf16(v0[j].x, v0[j].y); w0.y = cvt_pk_bf16(v0[j].z, v0[j].w); w1.x = cvt_pk_bf16(v1[j].x, v1[j].y); w1.y = cvt_pk_bf16(v1[j].z, v1[j].w);
                *(u32x2*)(XB + (size_t)m * D + c) = w0; *(u32x2*)(XB + (size_t)(m + 1) * D + c) = w1; }
            const float r0 = __builtin_amdgcn_rsqf(wave_sum(sumsq8(v0)) * (1.0f / D) + EPS), r1 = __builtin_amdgcn_rsqf(wave_sum(sumsq8(v1)) * (1.0f / D) + EPS);
#pragma unroll
            for (int j = 0; j < 8; ++j) { const int c = 4 * F.lane + 256 * j; const f32x4 y0 = v0[j] * r0 * gs[j] + hv[j], y1 = v1[j] * r1 * gs[j] + hv[j];
                u32x2 w0, w1; w0.x = cvt_pk_bf16(y0.x, y0.y); w0.y = cvt_pk_bf16(y0.z, y0.w); w1.x = cvt_pk_bf16(y1.x, y1.y); w1.y = cvt_pk_bf16(y1.z, y1.w);
                *(u32x2*)(H + (size_t)m * D + c) = w0; *(u32x2*)(H + (size_t)(m + 1) * D + c) = w1; } }
        else { const bf16_t* b0 = XB + (size_t)m * D + 8 * F.lane; u32x4 w[4][4];
#pragma unroll
            for (int rr = 0; rr < 4; ++rr)
#pragma unroll
                for (int j = 0; j < 4; ++j) w[rr][j] = *(const u32x4*)(b0 + (size_t)rr * D + 512 * j);
            SCHED_FENCE();
#pragma unroll
            for (int rr = 0; rr < 4; ++rr) { f32x4 v[8]; unpack_row(w[rr], v);
                const float r = __builtin_amdgcn_rsqf(wave_sum(sumsq8(v)) * (1.0f / D) + EPS);
#pragma unroll
                for (int j = 0; j < 4; ++j) *(u32x4*)(H + (size_t)(m + rr) * D + 8 * F.lane + 512 * j) = pack8(v[2 * j] * r * gs[2 * j] + hv[2 * j], v[2 * j + 1] * r * gs[2 * j + 1] + hv[2 * j + 1]); } }
    }
}
__device__ __forceinline__ void final_norm_phase(Frame& F, const float* g_final) {
    const bf16_t* XB = (const bf16_t*)(F.ws + WS_XB);
    const int per = 4 * ((MTOK / 4 + F.NGW - 1) / F.NGW), m0 = F.gw * per;
    f32x4 gg[8];
#pragma unroll
    for (int j = 0; j < 8; ++j) gg[j] = *(const f32x4*)(g_final + 8 * F.lane + 512 * (j >> 1) + 4 * (j & 1));
#pragma unroll 1
    for (int i = 0; i < per; i += 4) { const int m = m0 + i; if (m >= MTOK) break;
        const bf16_t* b0 = XB + (size_t)m * D + 8 * F.lane; u32x4 w[4][4];
#pragma unroll
        for (int rr = 0; rr < 4; ++rr)
#pragma unroll
            for (int j = 0; j < 4; ++j) w[rr][j] = *(const u32x4*)(b0 + (size_t)rr * D + 512 * j);
        SCHED_FENCE();
#pragma unroll
        for (int rr = 0; rr < 4; ++rr) { f32x4 v[8]; unpack_row(w[rr], v);
            const float r = __builtin_amdgcn_rsqf(wave_sum(sumsq8(v)) * (1.0f / D) + EPS);
            float* xr = F.out + (size_t)(m + rr) * D + 8 * F.lane;
#pragma unroll
            for (int j = 0; j < 8; ++j) *(f32x4*)(xr + 512 * (j >> 1) + 4 * (j & 1)) = v[j] * r * gg[j]; } }
}
__device__ __forceinline__ void pool_phase(Frame& F) {
    const bf16_t* P = (const bf16_t*)(F.ws + WS_P); bf16_t* BR = (bf16_t*)(F.ws + WS_BR);
    for (int it = F.bid * NTHREADS + F.tid; it < MTOK * 64; it += F.G * NTHREADS) {
        const int m = it >> 6, c = it & 63, s = seq_of_row(m), st = seq_start(s), T = seq_len(s), pos = m - st, half = 1 << (c >> 4);
        const int lo = max(pos - half, 0), hi = min(pos + half, T);
        u32x4 w[16]; const u32x4 z = (u32x4){0u, 0u, 0u, 0u};
#pragma unroll
        for (int k = 0; k < 16; ++k) { const int t = lo + k; w[k] = (t < hi) ? *(const u32x4*)(P + (size_t)(st + t) * INW + 8 * c) : z; }
        const u32x4 ws = *(const u32x4*)(P + (size_t)m * INW + 8 * c);
        float a[8];
#pragma unroll
        for (int e = 0; e < 8; ++e) a[e] = 0.f;
#pragma unroll
        for (int k = 0; k < 16; ++k) { a[0] += bflo(w[k].x); a[1] += bfhi(w[k].x); a[2] += bflo(w[k].y); a[3] += bfhi(w[k].y); a[4] += bflo(w[k].z); a[5] += bfhi(w[k].z); a[6] += bflo(w[k].w); a[7] += bfhi(w[k].w); }
        const float ic = fast_rcp((float)(hi - lo));
        u32x4 o; o.x = cvt_pk_bf16(a[0] * ic - bflo(ws.x), a[1] * ic - bfhi(ws.x)); o.y = cvt_pk_bf16(a[2] * ic - bflo(ws.y), a[3] * ic - bfhi(ws.y));
        o.z = cvt_pk_bf16(a[4] * ic - bflo(ws.z), a[5] * ic - bfhi(ws.z)); o.w = cvt_pk_bf16(a[6] * ic - bflo(ws.w), a[7] * ic - bfhi(ws.w));
        *(u32x4*)(BR + (size_t)m * D + 8 * c) = o;
    }
}
__device__ __forceinline__ void conv_fix_phase(Frame& F, int l, const float* conv_w, const float* conv_b) {
    const bf16_t* YB = (const bf16_t*)(F.ws + WS_Y); bf16_t* ACT = (bf16_t*)(F.ws + WS_ACT);
    const float* cw = conv_w + (size_t)l * 3 * NUP; const float* cb = conv_b + (size_t)l * NUP;
    for (int it = F.bid * NTHREADS + F.tid; it < 384 * 2 * 704; it += F.G * NTHREADS) {
        const int c = it % 704, be = it / 704, edge = be & 1, blk = be >> 1, row = blk * 64 + (edge ? 63 : 0);
        const int s = seq_of_row(row), pos = row - seq_start(s); const bool hasp = pos > 0, hasn = pos < seq_len(s) - 1;
        const u32x4 z = (u32x4){0u, 0u, 0u, 0u};
        const bf16_t* rp = edge ? YB + ((size_t)blk * 4 + 2) * NUP : YB + ((size_t)(blk - 1) * 4 + 3) * NUP;
        const bf16_t* rc = YB + ((size_t)blk * 4 + (edge ? 3 : 0)) * NUP;
        const bf16_t* rn = edge ? YB + ((size_t)(blk + 1) * 4 + 0) * NUP : YB + ((size_t)blk * 4 + 1) * NUP;
        const bool okp = edge ? true : hasp, okn = edge ? hasn : true;
        float o[8];
#pragma unroll
        for (int hb = 0; hb < 2; ++hb) { const int col = hb * DFF + 8 * c; float uv[8];
            const u32x4 yp = okp ? *(const u32x4*)(rp + col) : z, yc = *(const u32x4*)(rc + col), yn = okn ? *(const u32x4*)(rn + col) : z;
            const f32x4 w0a = *(const f32x4*)(cw + col), w0b = *(const f32x4*)(cw + col + 4), w1a = *(const f32x4*)(cw + NUP + col), w1b = *(const f32x4*)(cw + NUP + col + 4), w2a = *(const f32x4*)(cw + 2 * NUP + col), w2b = *(const f32x4*)(cw + 2 * NUP + col + 4);
            const f32x4 ba = *(const f32x4*)(cb + col), bb = *(const f32x4*)(cb + col + 4);
            uv[0] = bflo(yp.x) * w0a[0] + bflo(yc.x) * w1a[0] + bflo(yn.x) * w2a[0] + ba[0]; uv[1] = bfhi(yp.x) * w0a[1] + bfhi(yc.x) * w1a[1] + bfhi(yn.x) * w2a[1] + ba[1];
            uv[2] = bflo(yp.y) * w0a[2] + bflo(yc.y) * w1a[2] + bflo(yn.y) * w2a[2] + ba[2]; uv[3] = bfhi(yp.y) * w0a[3] + bfhi(yc.y) * w1a[3] + bfhi(yn.y) * w2a[3] + ba[3];
            uv[4] = bflo(yp.z) * w0b[0] + bflo(yc.z) * w1b[0] + bflo(yn.z) * w2b[0] + bb[0]; uv[5] = bfhi(yp.z) * w0b[1] + bfhi(yc.z) * w1b[1] + bfhi(yn.z) * w2b[1] + bb[1];
            uv[6] = bflo(yp.w) * w0b[2] + bflo(yc.w) * w1b[2] + bflo(yn.w) * w2b[2] + bb[2]; uv[7] = bfhi(yp.w) * w0b[3] + bfhi(yc.w) * w1b[3] + bfhi(yn.w) * w2b[3] + bb[3];
#pragma unroll
            for (int e = 0; e < 8; ++e) o[e] = hb ? o[e] * uv[e] : gelu_tanh(uv[e]); }
        u32x4 w; w.x = cvt_pk_bf16(o[0], o[1]); w.y = cvt_pk_bf16(o[2], o[3]); w.z = cvt_pk_bf16(o[4], o[5]); w.w = cvt_pk_bf16(o[6], o[7]);
        *(u32x4*)(ACT + (size_t)row * DFF + 8 * c) = w;
    }
}
constexpr int NA_SLOTS = 9;
constexpr int NAK_PITCH = 144, NAK_ROW = 64 * NAK_PITCH, NAK_BYTES = NA_SLOTS * NAK_ROW;
constexpr int NAV_PITCH = NA_SLOTS * 128 + 16, NAV_BYTES = 64 * NAV_PITCH;
constexpr int NA_RPB_OFF = NAK_BYTES + NAV_BYTES;
static_assert(NA_RPB_OFF + 465 * 4 <= LDS_MISC, "neighbourhood ring does not fit");
__device__ __forceinline__ void na_item(int I, int& s, int& h, int& r) { if (I < 2048) { s = I >> 10; h = (I >> 7) & 7; r = I & 127; } else { const int J = I - 2048; s = 2 + (J >> 9); h = (J >> 6) & 7; r = J & 63; } }
__device__ __forceinline__ void na_phase(Frame& F, int l, const float* rpb0, int part) {
    const bf16_t* P = (const bf16_t*)(F.ws + WS_P); const bf16_t* PT = (const bf16_t*)(F.ws + WS_PT); bf16_t* BR = (bf16_t*)(F.ws + WS_BR);
    const float* rpb = rpb0 + (size_t)l * 8 * 465;
    const int lane = F.lane, x = lane & 15, g = lane >> 4, qb = F.wave & 3, it = F.wave >> 2, tid = F.tid;
    LAS unsigned char* kr_ = F.lds; LAS unsigned char* vr_ = F.lds + NAK_BYTES; LAS float* rl = (LAS float*)(F.lds + NA_RPB_OFF);
    int I0, I1;
    if (F.G == 256) { const int c_ = F.bid; const int st0 = part == 0 ? (c_ < 128 ? 4 * c_ : 512 + 6 * (c_ - 128)) : 1280 + 2 * (c_ - 128), ns = part == 0 ? (c_ < 128 ? 4 : 6) : (c_ < 128 ? 0 : 2); I0 = 2 * st0; I1 = I0 + 2 * ns; }
    else { const int per = 2 * ((1536 + F.G - 1) / F.G); I0 = part == 0 ? F.bid * per : 0; I1 = part == 0 ? min(I0 + per, 3072) : 0; }
    const int w0 = qb == 0 ? 0 : (qb == 1 ? 8 : (qb == 2 ? 24 : 32));
    int cs = -1, ch = -1, hi = 0;
    const int ckey = tid >> 3, cch = tid & 7;
    u32x4 pk[2], pv[2]; int prow = -1;
    pk[0] = pk[1] = pv[0] = pv[1] = (u32x4){0u, 0u, 0u, 0u};
    for (int I = I0; I < I1; I += 2) {
        int s, h, r; na_item(I, s, h, r); const int rows = seq_len(s) >> 6, st = seq_start(s);
        const int rsA = min(max(r - 4, 0), rows - 8), rsB = min(max(r - 3, 0), rows - 8);
        const bool fresh = (s != cs) || (h != ch) || (rsA + 9 < hi) || (rsA > hi);
        const int lo_new = fresh ? rsA : hi, hi_new = rsB + 8;
        __syncthreads();
        if (fresh && (s != cs || h != ch)) { for (int i = tid; i < 465; i += NTHREADS) rl[i] = rpb[(size_t)h * 465 + i]; }
        for (int kr = lo_new; kr < hi_new; ++kr) { const int slot = kr % NA_SLOTS, tok0 = st + kr * 64; u32x4 kv, vv;
            if (!fresh && kr == prow) { kv = pk[0]; vv = pv[0]; }
            else if (!fresh && kr == prow + 1 && prow >= 0) { kv = pk[1]; vv = pv[1]; }
            else { kv = *(const u32x4*)(P + (size_t)(tok0 + ckey) * INW + 3584 + h * 64 + 8 * cch); vv = *(const u32x4*)(PT + (size_t)(1024 + h * 64 + ckey) * MTOK + tok0 + 8 * cch); }
            *(LAS u32x4*)(kr_ + slot * NAK_ROW + ckey * NAK_PITCH + 16 * cch) = kv;
            *(LAS u32x4*)(vr_ + ckey * NAV_PITCH + (slot * 64 + 8 * cch) * 2) = vv; }
        cs = s; ch = h; hi = hi_new; prow = -1;
        if (I + 2 < I1) {
            int s2, h2, r2; na_item(I + 2, s2, h2, r2); const int rows2 = seq_len(s2) >> 6, rsA2 = min(max(r2 - 4, 0), rows2 - 8), rsB2 = min(max(r2 - 3, 0), rows2 - 8);
            if (s2 == s && h2 == h && rsA2 <= hi && rsA2 + 9 >= hi && rsB2 + 8 > hi) { prow = hi;
#pragma unroll
                for (int j = 0; j < 2; ++j) { const int kr = min(hi + j, rows - 1), tok0 = st + kr * 64;
                    pk[j] = *(const u32x4*)(P + (size_t)(tok0 + ckey) * INW + 3584 + h * 64 + 8 * cch); pv[j] = *(const u32x4*)(PT + (size_t)(1024 + h * 64 + ckey) * MTOK + tok0 + 8 * cch); } } }
        const int rq = r + it, rs = it ? rsB : rsA;
        const int qtok = st + rq * 64 + 16 * qb + x;
        const bf16x8 q0 = *(const bf16x8*)(P + (size_t)qtok * INW + 3072 + h * 64 + 8 * g), q1 = *(const bf16x8*)(P + (size_t)qtok * INW + 3072 + h * 64 + 32 + 8 * g);
        __syncthreads();
        f32x4 S[16];
#pragma unroll
        for (int T = 0; T < 16; ++T) { const LAS unsigned char* kp = kr_ + ((rs + (T >> 1)) % NA_SLOTS) * NAK_ROW + (w0 + 16 * (T & 1) + x) * NAK_PITCH + 16 * g;
            f32x4 a = (f32x4){0.f, 0.f, 0.f, 0.f}; a = mfma16(*(const LAS bf16x8*)kp, q0, a); a = mfma16(*(const LAS bf16x8*)(kp + 64), q1, a); S[T] = a; }
        const int c = 16 * qb + x, cst = min(max(c - 8, 0), 48); float mx = -3.0e38f;
#pragma unroll
        for (int T = 0; T < 16; ++T) { const int dr = (rs + (T >> 1) - rq) + 7; const LAS float* rb = rl + dr * 31;
#pragma unroll
            for (int e = 0; e < 4; ++e) { const int kc = w0 + 16 * (T & 1) + 4 * g + e; const bool ok = (kc >= cst) && (kc < cst + 16); const int dc = min(max(kc - c, -15), 15) + 15;
                const float v = ok ? S[T][e] * 0.125f + rb[dc] : -1.0e30f; S[T][e] = v; mx = fmaxf(mx, v); } }
        mx = fmaxf(mx, __shfl_xor(mx, 16)); mx = fmaxf(mx, __shfl_xor(mx, 32));
        float sum = 0.f;
#pragma unroll
        for (int T = 0; T < 16; ++T)
#pragma unroll
            for (int e = 0; e < 4; ++e) { const float p = fast_exp(S[T][e] - mx); S[T][e] = p; sum += p; }
        sum += __shfl_xor(sum, 16); sum += __shfl_xor(sum, 32);
        const float inv = fast_rcp(sum);
        f32x4 O[4];
#pragma unroll
        for (int e2 = 0; e2 < 4; ++e2) O[e2] = (f32x4){0.f, 0.f, 0.f, 0.f};
#pragma unroll
        for (int ks = 0; ks < 8; ++ks) {
            u32x4 pw; pw.x = cvt_pk_bf16(S[2 * ks][0], S[2 * ks][1]); pw.y = cvt_pk_bf16(S[2 * ks][2], S[2 * ks][3]); pw.z = cvt_pk_bf16(S[2 * ks + 1][0], S[2 * ks + 1][1]); pw.w = cvt_pk_bf16(S[2 * ks + 1][2], S[2 * ks + 1][3]);
            const bf16x8 pf = __builtin_bit_cast(bf16x8, pw); const int kb = (((rs + ks) % NA_SLOTS) * 64 + w0 + 4 * g) * 2;
#pragma unroll
            for (int e2 = 0; e2 < 4; ++e2) { const LAS unsigned char* vp = vr_ + (16 * e2 + x) * NAV_PITCH + kb; const u32x2 lo = *(const LAS u32x2*)vp, hi2 = *(const LAS u32x2*)(vp + 32);
                u32x4 vw; vw.x = lo.x; vw.y = lo.y; vw.z = hi2.x; vw.w = hi2.y; O[e2] = mfma16(__builtin_bit_cast(bf16x8, vw), pf, O[e2]); } }
#pragma unroll
        for (int e2 = 0; e2 < 4; ++e2) { u32x2 w; w.x = cvt_pk_bf16(O[e2][0] * inv, O[e2][1] * inv); w.y = cvt_pk_bf16(O[e2][2] * inv, O[e2][3] * inv);
            *(u32x2*)(BR + (size_t)qtok * D + 1536 + h * 64 + 16 * e2 + 4 * g) = w; }
    }
    __syncthreads();
}
__device__ __forceinline__ float log2_sigmoid(float x) { return -__builtin_amdgcn_logf(1.0f + __builtin_amdgcn_exp2f(-x * 1.4426950408889634f)); }
constexpr int RT_PITCH = 272, RT_TILE = 128 * RT_PITCH;
__device__ __forceinline__ void decode_chunk(int u, int& s, int& h, int& n) { if (u < 512) { s = u >> 8; h = (u >> 6) & 3; n = u & 63; } else { const int v = u - 512; s = 2 + (v >> 7); h = (v >> 5) & 3; n = v & 31; } }
__device__ __forceinline__ void tile_load4(const bf16_t* src, size_t src_pitch, int tid, u32x4 (&v)[4]) {
#pragma unroll
    for (int i = 0; i < 4; ++i) { const int idx = tid + 512 * i, r = idx >> 4, ch = idx & 15; v[i] = *(const u32x4*)(src + (size_t)r * src_pitch + ch * 8); }
}
__device__ __forceinline__ void tile_store4(LAS unsigned char* dst, int tid, const u32x4 (&v)[4]) {
#pragma unroll
    for (int i = 0; i < 4; ++i) { const int idx = tid + 512 * i, r = idx >> 4, ch = idx & 15; *(LAS u32x4*)(dst + r * RT_PITCH + ch * 16) = v[i]; }
}
#define LDS_FRAG(tile, row, col) (*(const LAS bf16x8*)((tile) + (row) * RT_PITCH + (col) * 2))
__device__ __forceinline__ void ret_kv_phase(Frame& F, int l, const float* decay_f, const float* decay_b) {
    const bf16_t* P = (const bf16_t*)(F.ws + WS_P); const bf16_t* PT = (const bf16_t*)(F.ws + WS_PT); bf16_t* KV = (bf16_t*)(F.ws + WS_KV);
    const int lane = F.lane, x = lane & 15, g = lane >> 4, et = F.wave;
    LAS unsigned char* tK = F.lds; LAS unsigned char* tV = F.lds + RT_TILE;
    const int nun = (768 - F.bid + F.G - 1) / F.G;
#pragma unroll 1
    for (int ui_ = 0; ui_ < nun; ++ui_) { const int u = F.bid + ui_ * F.G;
        int s, h, n; decode_chunk(u, s, h, n); const int j0 = seq_start(s) + 128 * n;
        const float lgf = log2_sigmoid(decay_f[l * 4 + h]), lgb = log2_sigmoid(decay_b[l * 4 + h]);
        u32x4 a[4], b[4];
        tile_load4(P + (size_t)j0 * INW + 1536 + h * 128, INW, F.tid, a); tile_load4(PT + (size_t)(512 + h * 128) * MTOK + j0, MTOK, F.tid, b);
        __syncthreads();
        tile_store4(tK, F.tid, a); tile_store4(tV, F.tid, b);
        __syncthreads();
        f32x4 af[8], ab[8];
#pragma unroll
        for (int dt = 0; dt < 8; ++dt) { af[dt] = (f32x4){0.f, 0.f, 0.f, 0.f}; ab[dt] = (f32x4){0.f, 0.f, 0.f, 0.f}; }
#pragma unroll
        for (int ks = 0; ks < 4; ++ks) {
            const u32x4 vw = *(const LAS u32x4*)(tV + (16 * et + x) * RT_PITCH + (32 * ks + 8 * g) * 2);
            float v[8] = {bflo(vw.x), bfhi(vw.x), bflo(vw.y), bfhi(vw.y), bflo(vw.z), bfhi(vw.z), bflo(vw.w), bfhi(vw.w)}; float vf[8], vb[8];
#pragma unroll
            for (int e = 0; e < 8; ++e) { const int j = 32 * ks + 8 * g + e; vf[e] = v[e] * __builtin_amdgcn_exp2f(lgf * (float)(127 - j)); vb[e] = v[e] * __builtin_amdgcn_exp2f(lgb * (float)j); }
            u32x4 wf, wb; wf.x = cvt_pk_bf16(vf[0], vf[1]); wf.y = cvt_pk_bf16(vf[2], vf[3]); wf.z = cvt_pk_bf16(vf[4], vf[5]); wf.w = cvt_pk_bf16(vf[6], vf[7]);
            wb.x = cvt_pk_bf16(vb[0], vb[1]); wb.y = cvt_pk_bf16(vb[2], vb[3]); wb.z = cvt_pk_bf16(vb[4], vb[5]); wb.w = cvt_pk_bf16(vb[6], vb[7]);
            const bf16x8 bfv = __builtin_bit_cast(bf16x8, wf), bbv = __builtin_bit_cast(bf16x8, wb);
#pragma unroll
            for (int dt = 0; dt < 8; ++dt) {
                const LAS unsigned char* kp = tK + (32 * ks + 8 * g + (x >> 2)) * RT_PITCH + (16 * dt + 4 * (x & 3)) * 2;
                const bf16x4 k0 = __builtin_amdgcn_ds_read_tr16_b64_v4i16((LAS bf16x4*)kp), k1 = __builtin_amdgcn_ds_read_tr16_b64_v4i16((LAS bf16x4*)(kp + 4 * RT_PITCH));
                const bf16x8 kf = __builtin_shufflevector(k0, k1, 0, 1, 2, 3, 4, 5, 6, 7); af[dt] = mfma16(kf, bfv, af[dt]); ab[dt] = mfma16(kf, bbv, ab[dt]); }
        }
        bf16_t* o = KV + (size_t)u * 2 * 16384 + (size_t)(16 * et + x) * 128 + 4 * g;
#pragma unroll
        for (int dt = 0; dt < 8; ++dt) { u32x2 wf, wb; wf.x = cvt_pk_bf16(af[dt][0], af[dt][1]); wf.y = cvt_pk_bf16(af[dt][2], af[dt][3]); wb.x = cvt_pk_bf16(ab[dt][0], ab[dt][1]); wb.y = cvt_pk_bf16(ab[dt][2], ab[dt][3]);
            *(u32x2*)(o + 16 * dt) = wf; *(u32x2*)(o + 16384 + 16 * dt) = wb; }
    }
    __syncthreads();
}
__device__ __forceinline__ void ret_scan_phase(Frame& F, int l, const float* decay_f, const float* decay_b) {
    const bf16_t* KV = (const bf16_t*)(F.ws + WS_KV); bf16_t* RT = (bf16_t*)(F.ws + WS_RT);
    for (int it = F.bid * NTHREADS + F.tid; it < 16 * 2 * 4096; it += F.G * NTHREADS) {
        const int q = it & 4095, dir = (it >> 12) & 1, sh = it >> 13, s = sh >> 2, h = sh & 3; const int N = seq_len(s) >> 7; const int ubase = s < 2 ? s * 256 + h * 64 : 512 + (s - 2) * 128 + h * 32;
        const float lg = log2_sigmoid((dir ? decay_b : decay_f)[l * 4 + h]); const float cd = __builtin_amdgcn_exp2f(lg * 128.0f);
        f32x4 stv = (f32x4){0.f, 0.f, 0.f, 0.f};
#pragma unroll 1
        for (int k0 = 0; k0 < N; k0 += 8) { u32x2 kv[8]; size_t off[8];
#pragma unroll
            for (int j = 0; j < 8; ++j) { const int k = k0 + j, n = dir ? (N - 1 - k) : k; off[j] = ((size_t)(ubase + n) * 2 + dir) * 16384 + (size_t)q * 4; kv[j] = *(const u32x2*)(KV + off[j]); }
#pragma unroll
            for (int j = 0; j < 8; ++j) { u32x2 w; w.x = cvt_pk_bf16(stv[0], stv[1]); w.y = cvt_pk_bf16(stv[2], stv[3]); *(u32x2*)(RT + off[j]) = w; stv = stv * cd + (f32x4){bflo(kv[j].x), bfhi(kv[j].x), bflo(kv[j].y), bfhi(kv[j].y)}; } }
    }
}
__device__ __forceinline__ void ret_out_phase(Frame& F, int l, const float* decay_f, const float* decay_b) {
    const bf16_t* P = (const bf16_t*)(F.ws + WS_P); const bf16_t* PT = (const bf16_t*)(F.ws + WS_PT); const bf16_t* RT = (const bf16_t*)(F.ws + WS_RT); bf16_t* BR = (bf16_t*)(F.ws + WS_BR);
    const int lane = F.lane, x = lane & 15, g = lane >> 4, ti = F.wave;
    LAS unsigned char* tK = F.lds; LAS unsigned char* tV = F.lds + RT_TILE; LAS unsigned char* tF = F.lds + 2 * RT_TILE; LAS unsigned char* tB = F.lds + 3 * RT_TILE;
    LAS unsigned char* pl = tK + 16 * ti * RT_PITCH;
    const int nun = (768 - F.bid + F.G - 1) / F.G;
#pragma unroll 1
    for (int ui_ = 0; ui_ < nun; ++ui_) { const int u = F.bid + ui_ * F.G;
        int s, h, n; decode_chunk(u, s, h, n);
        const int j0 = seq_start(s) + 128 * n, il = 16 * ti + x, itok = j0 + il;
        const float lgf = log2_sigmoid(decay_f[l * 4 + h]), lgb = log2_sigmoid(decay_b[l * 4 + h]);
        u32x4 a[4], b[4], c[4], d[4]; bf16x8 qf[4]; u32x2 gw[8];
        tile_load4(P + (size_t)j0 * INW + 1536 + h * 128, INW, F.tid, a); tile_load4(PT + (size_t)(512 + h * 128) * MTOK + j0, MTOK, F.tid, b);
        tile_load4(RT + (size_t)u * 2 * 16384, 128, F.tid, c); tile_load4(RT + (size_t)u * 2 * 16384 + 16384, 128, F.tid, d);
#pragma unroll
        for (int ks = 0; ks < 4; ++ks) qf[ks] = *(const bf16x8*)(P + (size_t)itok * INW + 1024 + h * 128 + 32 * ks + 8 * g);
#pragma unroll
        for (int et = 0; et < 8; ++et) gw[et] = *(const u32x2*)(P + (size_t)itok * INW + 2560 + h * 128 + 16 * et + 4 * g);
        __syncthreads();
        tile_store4(tK, F.tid, a); tile_store4(tV, F.tid, b); tile_store4(tF, F.tid, c); tile_store4(tB, F.tid, d);
        __syncthreads();
        f32x4 S[8];
#pragma unroll
        for (int jt = 0; jt < 8; ++jt) { f32x4 acc = (f32x4){0.f, 0.f, 0.f, 0.f};
#pragma unroll
            for (int ks = 0; ks < 4; ++ks) acc = mfma16(LDS_FRAG(tK, 16 * jt + x, 32 * ks + 8 * g), qf[ks], acc);
#pragma unroll
            for (int e = 0; e < 4; ++e) { const int dl = il - (16 * jt + 4 * g + e); acc[e] *= dl >= 0 ? __builtin_amdgcn_exp2f(lgf * (float)dl) : __builtin_amdgcn_exp2f(lgb * (float)(-dl)); }
            S[jt] = acc; }
        f32x4 O[8];
        const float cf = __builtin_amdgcn_exp2f(lgf * (float)(il + 1)), cb = __builtin_amdgcn_exp2f(lgb * (float)(128 - il));
#pragma unroll
        for (int et = 0; et < 8; ++et) { f32x4 xf = (f32x4){0.f, 0.f, 0.f, 0.f}, xb = (f32x4){0.f, 0.f, 0.f, 0.f};
#pragma unroll
            for (int ks = 0; ks < 4; ++ks) { xf = mfma16(LDS_FRAG(tF, 16 * et + x, 32 * ks + 8 * g), qf[ks], xf); xb = mfma16(LDS_FRAG(tB, 16 * et + x, 32 * ks + 8 * g), qf[ks], xb); }
            O[et] = xf * cf + xb * cb; }
        __syncthreads();
#pragma unroll
        for (int jt = 0; jt < 8; ++jt) { u32x2 w; w.x = cvt_pk_bf16(S[jt][0], S[jt][1]); w.y = cvt_pk_bf16(S[jt][2], S[jt][3]); *(LAS u32x2*)(pl + x * RT_PITCH + (16 * jt + 4 * g) * 2) = w; }
#pragma unroll
        for (int ks = 0; ks < 4; ++ks) { const bf16x8 pf = LDS_FRAG(pl, x, 32 * ks + 8 * g);
#pragma unroll
            for (int et = 0; et < 8; ++et) O[et] = mfma16(LDS_FRAG(tV, 16 * et + x, 32 * ks + 8 * g), pf, O[et]); }
        float sm = 0.f;
#pragma unroll
        for (int et = 0; et < 8; ++et) sm += (O[et][0] + O[et][1]) + (O[et][2] + O[et][3]);
        sm += __shfl_xor(sm, 16); sm += __shfl_xor(sm, 32); const float mu = sm * (1.0f / 128.0f);
        float vq = 0.f;
#pragma unroll
        for (int et = 0; et < 8; ++et) { const f32x4 dd = O[et] - mu; vq += (dd[0] * dd[0] + dd[1] * dd[1]) + (dd[2] * dd[2] + dd[3] * dd[3]); }
        vq += __shfl_xor(vq, 16); vq += __shfl_xor(vq, 32); const float rstd = __builtin_amdgcn_rsqf(vq * (1.0f / 128.0f) + EPS);
#pragma unroll
        for (int et = 0; et < 8; ++et) { const float g0 = bflo(gw[et].x), g1 = bfhi(gw[et].x), g2 = bflo(gw[et].y), g3 = bfhi(gw[et].y);
            u32x2 w; w.x = cvt_pk_bf16((O[et][0] - mu) * rstd * g0 * sigmoidf_(g0), (O[et][1] - mu) * rstd * g1 * sigmoidf_(g1)); w.y = cvt_pk_bf16((O[et][2] - mu) * rstd * g2 * sigmoidf_(g2), (O[et][3] - mu) * rstd * g3 * sigmoidf_(g3));
            *(u32x2*)(BR + (size_t)itok * D + 1024 + h * 128 + 16 * et + 4 * g) = w; }
    }
    __syncthreads();
}

#define I_X_PROMPT (ap_->in[0])
#define I_X_SAMPLE (ap_->in[1])
#define I_C_PROMPT (ap_->in[2])
#define I_C_SAMPLE (ap_->in[3])
#define I_W_ADA (ap_->in[4])
#define I_B_ADA (ap_->in[5])
#define I_G_MIX (ap_->in[6])
#define I_W_IN (ap_->in[7])
#define I_POOL_W (ap_->in[8])
#define I_POOL_SCALE (ap_->in[9])
#define I_DECAY_F (ap_->in[10])
#define I_DECAY_B (ap_->in[11])
#define I_RPB (ap_->in[12])
#define I_W_BRANCH (ap_->in[13])
#define I_W_GATE (ap_->in[14])
#define I_B_GATE (ap_->in[15])
#define I_W_OUT (ap_->in[16])
#define I_G_FFN (ap_->in[17])
#define I_W_UP (ap_->in[18])
#define I_CONV_W (ap_->in[19])
#define I_CONV_B (ap_->in[20])
#define I_W_DOWN (ap_->in[21])
#define I_G_FINAL (ap_->in[22])
constexpr int PH_PER_LAYER = 11, PH_TOTAL = 2 + DEPTH * PH_PER_LAYER + 1;
__global__ void __launch_bounds__(NTHREADS, 2) fwd_kernel(Args args) {
    extern __shared__ __attribute__((aligned(16))) unsigned char lds_raw[];
    volatile LAS unsigned* MISC = (volatile LAS unsigned*)((LAS unsigned char*)lds_raw + LDS_MISC);
    if (threadIdx.x < 4) MISC[threadIdx.x] = 0u;
    __syncthreads();
    if (MK_N_LAUNCHES == 1) (void)xcd_barrier_post((unsigned*)(args.ws + WS_CTL) + 4096, MISC);
#if MK_N_LAUNCHES == 1
#define IN_PH() true
#define END_PH() do { XcdBarrier bar_; bar_.bar = (unsigned*)(args.ws + WS_CTL) + 4096; bar_.x = xb_xcc_id(); bar_.st = (volatile LAS unsigned*)((LAS unsigned char*)lds_raw + LDS_MISC); xcd_barrier(bar_); } while (0)
#else
    const int lo = args.ph_lo, hi = args.ph_hi; int ph = 0;
#define IN_PH() (lo <= ph && ph < hi)
#define END_PH() do { if (IN_PH() && ph + 1 < hi) { XcdBarrier bar_; bar_.bar = (unsigned*)(args.ws + WS_CTL) + 4096; bar_.x = xb_xcc_id(); bar_.st = (volatile LAS unsigned*)((LAS unsigned char*)lds_raw + LDS_MISC); xcd_barrier(bar_); } ++ph; } while (0)
#endif
#define PH_FRAME() Frame F; const __attribute__((address_space(4))) Args* ap_ = (const __attribute__((address_space(4))) Args*)__builtin_amdgcn_kernarg_segment_ptr(); asm volatile("" : "+s"(ap_)); \
        { int t_ = threadIdx.x; asm volatile("" : "+v"(t_)); unsigned char* w_ = ap_->ws; float* o_ = ap_->out; \
        unsigned l_ = 0; asm volatile("" : "+s"(l_)); F.lds = (LAS unsigned char*)lds_raw + l_; F.tid = t_; F.lane = t_ & 63; F.wave = __builtin_amdgcn_readfirstlane(t_ >> 6); int g_ = gridDim.x, b_ = blockIdx.x; asm volatile("" : "+s"(g_)); asm volatile("" : "+s"(b_)); F.G = g_; F.bid = b_; \
        F.gw = b_ * NWAVES + F.wave; F.NGW = F.G * NWAVES; F.out = o_; F.ws = w_; } \
        const float* mod = (const float*)(F.ws + WS_MOD); const int c = F.bid; (void)mod; (void)c; int l = l0; asm volatile("" : "+s"(l)); (void)l

    { const int l0 = 0;
    if (IN_PH()) { PH_FRAME(); prologue_mod_partial(F, I_C_PROMPT, I_C_SAMPLE, I_W_ADA); prologue_tables(F); convert_weights(F, 0, I_W_IN, I_W_GATE, I_W_BRANCH, I_W_OUT, I_W_UP, I_W_DOWN, I_POOL_W, I_POOL_SCALE, false); }
    END_PH();
    if (IN_PH()) { PH_FRAME(); prologue_mod_reduce(F, I_B_ADA); }
    END_PH(); }
#pragma unroll 1
    for (int l0 = 0; l0 < DEPTH; ++l0) {
#define LAYER_PTRS() const float* mod_l = mod + (size_t)l * 4 * 12288; const float* xp = (l == 0) ? I_X_PROMPT : F.out; const float* xs = (l == 0) ? I_X_SAMPLE - (size_t)16384 * D : F.out; (void)mod_l; (void)xp; (void)xs
        if (IN_PH()) { PH_FRAME(); LAYER_PTRS(); if (l > 0) convert_weights(F, l, I_W_IN, I_W_GATE, I_W_BRANCH, I_W_OUT, I_W_UP, I_W_DOWN, I_POOL_W, I_POOL_SCALE, true); __syncthreads(); if (l == 0) norm_phase<true>(F, xp, xs, I_G_MIX + (size_t)l * D, mod_l, 0, D); else norm_phase<false>(F, xp, xs, I_G_MIX + (size_t)l * D, mod_l, 0, D); }
        END_PH();
        if (IN_PH()) { PH_FRAME(); SchedG1 S{F.G, c, (const char*)(F.ws + WS_H), (const char*)(F.ws + WS_W1T)};
            EpiG1 E{(bf16_t*)(F.ws + WS_P), (bf16_t*)(F.ws + WS_PT), (bf16_t*)(F.ws + WS_GATES), I_B_GATE + (size_t)l * NGATE, (const float*)(F.ws + WS_ROPEC), (const float*)(F.ws + WS_ROPES), (const float*)(F.ws + WS_ROPECT), (const float*)(F.ws + WS_ROPEST)};
            pg8::gemm_phase<EpiG1, SchedG1>(F.lds, F.tid, 4096u, 4096u, (size_t)128 * 4096u, (size_t)128 * 4096u, S, E);
            convert_tail(F, l, I_W_IN, I_W_GATE, I_W_BRANCH, I_W_OUT, I_W_UP, I_W_DOWN, 96 * 50, CV_A, CV_QG1); }
        END_PH();
        if (IN_PH()) { { PH_FRAME(); SchedCDFT S{F.G, c, (const char*)(F.ws + WS_D2), (const char*)(F.ws + WS_P), 1}; EpiCDFT E{(bf16_t*)(F.ws + WS_YT)}; pg8::gemm_phase<EpiCDFT, SchedCDFT>(F.lds, F.tid, 256u, (unsigned)(64 * INW * 2), (size_t)128 * 256, (size_t)(INW * 2), S, E); }
            { PH_FRAME(); SchedCDFT S{F.G, c, (const char*)(F.ws + WS_D2), (const char*)(F.ws + WS_P), 0}; EpiCDFT E{(bf16_t*)(F.ws + WS_YT)}; pg8::gemm_phase<EpiCDFT, SchedCDFT>(F.lds, F.tid, 256u, (unsigned)(32 * INW * 2), (size_t)128 * 256, (size_t)(INW * 2), S, E); }
            { PH_FRAME(); pool_phase(F); }
            { PH_FRAME(); ret_kv_phase(F, l, I_DECAY_F, I_DECAY_B); }
            { PH_FRAME(); na_phase(F, l, I_RPB, 0); } }
        END_PH();
        if (IN_PH()) { { PH_FRAME(); ret_scan_phase(F, l, I_DECAY_F, I_DECAY_B); }
            { PH_FRAME(); SchedF1 S{F.G, c, (const char*)(F.ws + WS_A1), (const char*)(F.ws + WS_YT)}; EpiF1 E{(bf16_t*)(F.ws + WS_ZT), (const float*)(F.ws + WS_TWL), (const float*)(F.ws + WS_TWS)}; pg8::gemm_phase<EpiF1, SchedF1>(F.lds, F.tid, 512u, 512u, (size_t)128 * 512, (size_t)128 * 512, S, E); }
            { PH_FRAME(); na_phase(F, l, I_RPB, 1); } }
        END_PH();
        if (IN_PH()) { { PH_FRAME(); SchedF2 S{F.G, c, (const char*)(F.ws + WS_A2L), (const char*)(F.ws + WS_A2S), (const char*)(F.ws + WS_ZT)}; EpiF2 E{(bf16_t*)(F.ws + WS_BR)}; pg8::gemm_phase<EpiF2, SchedF2>(F.lds, F.tid, 256u, 256u, (size_t)128 * 256, (size_t)128 * 256, S, E); }
            { PH_FRAME(); ret_out_phase(F, l, I_DECAY_F, I_DECAY_B); } }
        END_PH();
        if (IN_PH()) {
            { PH_FRAME(); SchedMerge S{F.G, c, (const char*)(F.ws + WS_BR), (const char*)(F.ws + WS_WBRT)}; EpiMerge E{(bf16_t*)(F.ws + WS_MERGED), (const bf16_t*)(F.ws + WS_GATES), (const bf16_t*)(F.ws + WS_ZERO)}; pg8::gemm_phase<EpiMerge, SchedMerge>(F.lds, F.tid, 4096u, 1024u, (size_t)128 * 4096u, (size_t)128 * 1024u, S, E); } }
        END_PH();
        if (IN_PH()) { PH_FRAME(); LAYER_PTRS(); SchedPlain S{F.G, c, (const char*)(F.ws + WS_MERGED), (const char*)(F.ws + WS_WOUTT), 8, 32, 4096}; EpiRes E{(bf16_t*)(F.ws + WS_XB), mod_l + 2 * D};
            pg8::gemm_phase<EpiRes, SchedPlain>(F.lds, F.tid, 4096u, 4096u, (size_t)128 * 4096u, (size_t)128 * 4096u, S, E); }
        END_PH();
        if (IN_PH()) { PH_FRAME(); LAYER_PTRS(); norm_phase<false>(F, nullptr, nullptr, I_G_FFN + (size_t)l * D, mod_l, 3 * D, 4 * D); }
        END_PH();
        if (IN_PH()) { PH_FRAME(); SchedPlain S{F.G, c, (const char*)(F.ws + WS_H), (const char*)(F.ws + WS_WUPT), 44, 32, 4096}; EpiUpConv E{(bf16_t*)(F.ws + WS_ACT), (bf16_t*)(F.ws + WS_Y), I_CONV_W + (size_t)l * 3 * NUP, I_CONV_B + (size_t)l * NUP, F.lds + pg8::STAGE_BYTES};
            pg8::gemm_phase<EpiUpConv, SchedPlain>(F.lds, F.tid, 4096u, 4096u, (size_t)128 * 4096u, (size_t)128 * 4096u, S, E);
            if (l + 1 < DEPTH) convert_tail(F, l + 1, I_W_IN, I_W_GATE, I_W_BRANCH, I_W_OUT, I_W_UP, I_W_DOWN, 96 * 44, 0, CV_QUP); }
        END_PH();
        if (IN_PH()) { PH_FRAME(); conv_fix_phase(F, l, I_CONV_W, I_CONV_B); }
        END_PH();
        if (IN_PH()) { PH_FRAME(); LAYER_PTRS(); SchedPlain S{F.G, c, (const char*)(F.ws + WS_ACT), (const char*)(F.ws + WS_WDNT), 8, 88, 11264}; EpiRes E{(bf16_t*)(F.ws + WS_XB), mod_l + 5 * D};
            pg8::gemm_phase<EpiRes, SchedPlain>(F.lds, F.tid, 11264u, 11264u, (size_t)128 * 11264u, (size_t)128 * 11264u, S, E); }
        END_PH();
    }
    { const int l0 = 0; if (IN_PH()) { PH_FRAME(); final_norm_phase(F, I_G_FINAL); } }
#undef IN_PH
#undef END_PH
}

#ifdef DBG_CUT
__global__ void dbg_dump(const unsigned short* src, float* out, size_t n) { for (size_t i = (size_t)blockIdx.x * blockDim.x + threadIdx.x; i < n; i += (size_t)gridDim.x * blockDim.x) out[i] = __uint_as_float(((unsigned)src[i]) << 16); }
#endif
extern "C" void kernel_launch(void* const* d_in, const int* in_sizes, int n_in, void* d_out, int out_size, void* d_ws, size_t ws_size, hipStream_t stream) {
    static int grid = 0;
    if (grid == 0) {
        if (n_in != 23 || out_size != MTOK * D || ws_size < WS_END) { fprintf(stderr, "kernel_launch: unexpected sizes (n_in %d, out %d, ws %zu; need ws >= %zu); nothing launched\n", n_in, out_size, ws_size, (size_t)WS_END); grid = -1; return; }
        int dev = 0, cus = 0, per_cu = 0;
        if (hipGetDevice(&dev) != hipSuccess || hipDeviceGetAttribute(&cus, hipDeviceAttributeMultiprocessorCount, dev) != hipSuccess) { grid = -1; return; }
        if (hipFuncSetAttribute((const void*)fwd_kernel, hipFuncAttributeMaxDynamicSharedMemorySize, LDS_BYTES) != hipSuccess) { fprintf(stderr, "kernel_launch: hipFuncSetAttribute failed\n"); grid = -1; return; }
        if (hipOccupancyMaxActiveBlocksPerMultiprocessor(&per_cu, (const void*)fwd_kernel, NTHREADS, LDS_BYTES) != hipSuccess || per_cu < 1) { fprintf(stderr, "kernel_launch: occupancy query says %d blocks per CU\n", per_cu); }
        (void)hipGetLastError();
        grid = cus;
    }
    if (grid < 0) return;
    (void)hipMemsetAsync((char*)d_ws + WS_CTL, 0, CTL_ZERO_BYTES, stream);
#ifdef DBG_CLEAR_ALL
    (void)hipMemsetAsync((char*)d_ws + CTL_ZERO_BYTES, 0, WS_END - CTL_ZERO_BYTES, stream); (void)hipMemsetAsync(d_out, 0, (size_t)out_size * 4, stream);
#endif
    Args a{};
    for (int i = 0; i < 23; ++i) a.in[i] = (const float*)d_in[i];
    a.out = (float*)d_out; a.ws = (unsigned char*)d_ws;
#if MK_N_LAUNCHES == 1
    a.ph_lo = 0; a.ph_hi = PH_TOTAL;
    hipLaunchKernelGGL(fwd_kernel, dim3(grid), dim3(NTHREADS), LDS_BYTES, stream, a);
#else
#ifdef DBG_CUT
    for (int p = 0; p < DBG_CUT; ++p) { a.ph_lo = p; a.ph_hi = p + 1; hipLaunchKernelGGL(fwd_kernel, dim3(grid), dim3(NTHREADS), LDS_BYTES, stream, a); }
    hipLaunchKernelGGL(dbg_dump, dim3(2048), dim3(256), 0, stream, (const unsigned short*)((char*)d_ws + DBG_OFF), (float*)d_out, (size_t)DBG_N);
#else
    for (int p = 0; p < PH_TOTAL; ++p) { a.ph_lo = p; a.ph_hi = p + 1; hipLaunchKernelGGL(fwd_kernel, dim3(grid), dim3(NTHREADS), LDS_BYTES, stream, a); }
#endif
#endif
}
```

```cpp
#include <hip/hip_runtime.h>
#include <cstdio>
#include <cstdint>

#define LAS __attribute__((address_space(3)))
typedef unsigned short bf16_t;
typedef short bf16x8 __attribute__((ext_vector_type(8)));
typedef short bf16x4 __attribute__((ext_vector_type(4)));
typedef float f32x4 __attribute__((ext_vector_type(4)));
typedef float f32x2 __attribute__((ext_vector_type(2)));
typedef unsigned u32x4 __attribute__((ext_vector_type(4)));
typedef unsigned u32x2 __attribute__((ext_vector_type(2)));

#ifndef REP_MIX
#define REP_MIX 1
#endif
#ifndef REP_ELT
#define REP_ELT 1
#endif
#ifndef REP_DFT
#define REP_DFT 1
#endif
#ifndef REP_G1
#define REP_G1 1
#endif
#ifndef REP_UP
#define REP_UP 1
#endif
#define REPEAT(n) _Pragma("unroll 1") for (int r_ = 0; r_ < (n); ++r_)
#ifndef MK_N_LAUNCHES
#define MK_N_LAUNCHES 1
#endif

constexpr int D = 2048, DEPTH = 4, NSEQ = 4, MTOK = 24576;
constexpr int INW = 4608, DFF = 5632, NUP = 11264, NGATE = 8192;
constexpr int NWAVES = 8, NTHREADS = 512;
constexpr int LDS_BYTES = 163840, LDS_MISC = LDS_BYTES - 256;
constexpr float EPS = 1e-6f;

__host__ __device__ __forceinline__ int seq_start(int s) { return s < 2 ? s * 8192 : 16384 + (s - 2) * 4096; }
__host__ __device__ __forceinline__ int seq_len(int s) { return s < 2 ? 8192 : 4096; }
__host__ __device__ __forceinline__ int seq_of_row(int m) { return m < 16384 ? (m >> 13) : 2 + ((m - 16384) >> 12); }

constexpr size_t MiB = 1u << 20;
constexpr size_t WS_CTL = 0, CTL_ZERO_BYTES = 1 * MiB, WS_ZERO = 512 * 1024;
constexpr size_t WS_MOD = 1 * MiB;
constexpr size_t WS_MODP = 1318 * MiB;
constexpr size_t WS_ROPEC = 8 * MiB, WS_ROPES = 10 * MiB, WS_ROPECT = 12 * MiB, WS_ROPEST = 14 * MiB;
constexpr size_t WS_D2 = 16 * MiB;
constexpr size_t WS_A1 = WS_D2 + 256 * 1024;
constexpr size_t WS_A2L = WS_D2 + 512 * 1024;
constexpr size_t WS_A2S = WS_D2 + 640 * 1024;
constexpr size_t WS_TWL = WS_D2 + 768 * 1024;
constexpr size_t WS_TWS = WS_D2 + 896 * 1024;
constexpr size_t WS_ZT = 18 * MiB;
constexpr size_t WS_W1T = 274 * MiB;
constexpr size_t WS_WBRT = 324 * MiB;
constexpr size_t WS_WOUTT = 332 * MiB;
constexpr size_t WS_WUPT = 340 * MiB;
constexpr size_t WS_WDNT = 384 * MiB;
constexpr size_t WS_H = 406 * MiB;
constexpr size_t WS_P = 502 * MiB;
constexpr size_t WS_PT = 718 * MiB;
constexpr size_t WS_GATES = 790 * MiB;
constexpr size_t WS_BR = 1174 * MiB;
constexpr size_t WS_YT = 1270 * MiB;
constexpr size_t WS_KV = 1318 * MiB;
constexpr size_t WS_RT = 1414 * MiB;
constexpr size_t WS_MERGED = 1270 * MiB;
constexpr size_t WS_Y = 502 * MiB;
constexpr size_t WS_ACT = 1030 * MiB;
constexpr size_t WS_XB = 1462 * MiB;
constexpr size_t WS_END = 1558 * MiB;

typedef __bf16 bf16x2v __attribute__((ext_vector_type(2)));
__device__ __forceinline__ unsigned cvt_pk_bf16(float lo, float hi) { const f32x2 v = {lo, hi}; const bf16x2v b = __builtin_convertvector(v, bf16x2v); return __builtin_bit_cast(unsigned, b); }
__device__ __forceinline__ float bf2f(unsigned short b) { return __uint_as_float(((unsigned)b) << 16); }
__device__ __forceinline__ float bflo(unsigned w) { return __uint_as_float(w << 16); }
__device__ __forceinline__ float bfhi(unsigned w) { return __uint_as_float(w & 0xffff0000u); }
__device__ __forceinline__ float wave_sum(float v) {
#pragma unroll
    for (int o = 1; o < 64; o <<= 1) v += __shfl_xor(v, o);
    return v;
}
__device__ __forceinline__ float fast_exp(float x) { return __builtin_amdgcn_exp2f(x * 1.4426950408889634f); }
__device__ __forceinline__ float fast_rcp(float x) { return __builtin_amdgcn_rcpf(x); }
__device__ __forceinline__ float sigmoidf_(float x) { return fast_rcp(1.0f + fast_exp(-x)); }
constexpr float NLOG2E = -1.4426950408889634f;
__device__ __forceinline__ float sig2_(float t) { return fast_rcp(1.0f + __builtin_amdgcn_exp2f(t)); }
__device__ __forceinline__ float gelu_tanh(float u) { const float a = u * (u * u * 0.10294324f + 2.3022082f); const float r = fast_rcp(1.0f + __builtin_amdgcn_exp2f(a)); return u - u * r; }
__device__ __forceinline__ float dpp_ror1(float v) { return __builtin_bit_cast(float, __builtin_amdgcn_mov_dpp(__builtin_bit_cast(int, v), 0x121, 0xf, 0xf, false)); }
__device__ __forceinline__ float dpp_ror15(float v) { return __builtin_bit_cast(float, __builtin_amdgcn_mov_dpp(__builtin_bit_cast(int, v), 0x12f, 0xf, 0xf, false)); }
__device__ __forceinline__ f32x4 mfma16(bf16x8 a, bf16x8 b, f32x4 c) { return __builtin_amdgcn_mfma_f32_16x16x32_bf16(a, b, c, 0, 0, 0); }

#define SCHED_FENCE() __builtin_amdgcn_sched_barrier(0)
#define XB_TMO      128
#define XB_XCNT(j)  (256  + 64 * (j))
#define XB_XSUB(j)  (1280 + 64 * (j))
#define XB_XGEN(j)  (2304 + 64 * (j))
#define XB_TOP      3328
#define XB_TOPGEN   3392
#define XCD_BAR_WORDS 3456
#define XB_SPIN_CAP (1u << 22)

__device__ __forceinline__ unsigned xb_ld(unsigned* p)              { return __hip_atomic_load(p, __ATOMIC_RELAXED, __HIP_MEMORY_SCOPE_AGENT); }
__device__ __forceinline__ unsigned xb_add(unsigned* p, unsigned v) { return __hip_atomic_fetch_add(p, v, __ATOMIC_RELAXED, __HIP_MEMORY_SCOPE_AGENT); }
__device__ __forceinline__ unsigned xb_xcc_id() { return (unsigned)__builtin_amdgcn_s_getreg((3 << 11) | 20) & 0xFu; }
#define XB_SPIN(cond, bar) do { unsigned _sp = 0; while (cond) { __builtin_amdgcn_s_sleep(1); \
    if ((++_sp & 255u) == 0u) { if (xb_ld(&(bar)[XB_TMO])) break; if (_sp > XB_SPIN_CAP) { atomicAdd(&(bar)[XB_TMO], 1u); break; } } } } while (0)

struct XcdBarrier {
    unsigned* bar; unsigned x;
    volatile LAS unsigned* st;
};
__device__ __forceinline__ XcdBarrier xcd_barrier_post(unsigned* bar, volatile LAS unsigned* st) {
    XcdBarrier b; b.bar = bar; b.x = xb_xcc_id(); b.st = st;
    if (threadIdx.x == 0) (void)xb_add(&bar[XB_XCNT(b.x)], 1u);
    return b;
}
__device__ __forceinline__ void xcd_barrier_complete(unsigned* bar, unsigned x, unsigned& nloc, unsigned& nx) {
    const unsigned G = gridDim.x * gridDim.y * gridDim.z;
    unsigned sum, cnt, mine, sp = 0u;
    for (;;) {
        sum = 0u; cnt = 0u; mine = 0u;
#pragma unroll
        for (unsigned j = 0; j < 16; ++j) { const unsigned c = xb_ld(&bar[XB_XCNT(j)]); sum += c; cnt += (c > 0u) ? 1u : 0u; mine = (j == x) ? c : mine; }
        if (sum == G) break;
        __builtin_amdgcn_s_sleep(1);
        if ((++sp & 255u) == 0u) { if (xb_ld(&bar[XB_TMO])) break; if (sp > XB_SPIN_CAP) { atomicAdd(&bar[XB_TMO], 1u); break; } }
    }
    nloc = mine > 0u ? mine : 1u; nx = cnt > 0u ? cnt : 1u;
}
__device__ __forceinline__ void xcd_barrier(const XcdBarrier& b) {
    asm volatile("s_waitcnt vmcnt(0)" ::: "memory");
    __syncthreads();
    if (threadIdx.x == 0) {
        unsigned* bar = b.bar;
        __builtin_amdgcn_s_waitcnt(0);
        unsigned nloc = b.st[0], nx = b.st[1];
        if (nloc == 0u) { xcd_barrier_complete(bar, b.x, nloc, nx); b.st[0] = nloc; b.st[1] = nx; }
        const unsigned old = xb_add(&bar[XB_XSUB(b.x)], 1u);
        const unsigned gen = old / nloc;
        if (old + 1u == (gen + 1u) * nloc) {
            __builtin_amdgcn_fence(__ATOMIC_RELEASE, "agent");
            asm volatile("s_waitcnt vmcnt(0)" ::: "memory");
            const unsigned og = xb_add(&bar[XB_TOP], 1u);
            const unsigned tg = og / nx;
            if (og + 1u == (tg + 1u) * nx) xb_add(&bar[XB_TOPGEN], 1u);
            else XB_SPIN(xb_ld(&bar[XB_TOPGEN]) == tg, bar);
            __builtin_amdgcn_fence(__ATOMIC_ACQUIRE, "agent");
            xb_add(&bar[XB_XGEN(b.x)], 1u);
            asm volatile("s_waitcnt vmcnt(0)" ::: "memory");
        } else {
            XB_SPIN(xb_ld(&bar[XB_XGEN(b.x)]) == gen, bar);
            __builtin_amdgcn_fence(__ATOMIC_ACQUIRE, "agent");
            asm volatile("s_waitcnt vmcnt(0)" ::: "memory");
        }
    }
    __syncthreads();
}

namespace pg8 {
constexpr int BM = 256, BK = 64, HALF = 128, HTB = HALF * BK * 2, STAGE_BYTES = 8 * HTB, NXCD = 8, WGM = 8;
__host__ __device__ __forceinline__ int lds_byte(int r, int c) { const int st = (r >> 4) * 2 + (c >> 5), rr = r & 15, cc = c & 31, ob = rr * 64 + cc * 2; return st * 1024 + (ob ^ (((ob >> 9) & 1) << 5)); }
__host__ __device__ __forceinline__ void stage_rc(int b, int& R, int& C) { const int st = b / 1024, sb = b % 1024, swz = sb ^ (((sb >> 9) & 1) << 5); R = (st >> 1) * 16 + swz / 64; C = (st & 1) * 32 + (swz % 64) / 2; }
__host__ __device__ __forceinline__ int perm32(int rho) { const int n = rho >> 4, i = rho & 15; return 8 * (i >> 2) + 4 * n + (i & 3); }

struct Unit { const char* A; const char* B; int nt, kind, r0, c0, dst; };
__device__ __forceinline__ bool tile_order(int i, int G, int c, int nM, int nN, int& pm, int& pn) {
    const int nwg = nM * nN; const long L = (long)i * G + c; if (L >= nwg) return false;
    int wgid = (int)L; { const int q = nwg / NXCD, r = nwg % NXCD, xcd = wgid % NXCD, off = wgid / NXCD; wgid = (xcd < r ? xcd * (q + 1) : r * (q + 1) + (xcd - r) * q) + off; }
    const int nig = WGM * nN, gid = wgid / nig, fm = gid * WGM, gsz = (nM - fm) < WGM ? (nM - fm) : WGM;
    pm = fm + ((wgid % nig) % gsz); pn = (wgid % nig) / gsz; return true;
}

template <class Epi, class Sched>
__device__ __forceinline__ void gemm_phase(LAS unsigned char* lds, const int tid, const unsigned lda, const unsigned ldb, const size_t hstepA, const size_t hstepB, const Sched& S, const Epi& E) {
    const int wid = __builtin_amdgcn_readfirstlane(tid >> 6), lane = tid & 63, wr = wid >> 2, wc = wid & 3, fr = lane & 15, fq = lane >> 4;
    unsigned voffA[2], voffB[2];
#pragma unroll
    for (int i = 0; i < 2; ++i) { int R, C; stage_rc(tid * 16 + i * 8192, R, C); const int Rb = Epi::PERM ? ((R & ~31) + perm32(R & 31)) : R;
        const int Ra = Epi::APERM ? ((R & ~63) + 4 * (R & 15) + ((R >> 4) & 3)) : R;
        voffA[i] = (unsigned)Ra * lda + (unsigned)C * 2u; voffB[i] = (unsigned)Rb * ldb + (unsigned)C * 2u; }
    const size_t kstep = (size_t)(BK * 2);
    const unsigned ldsw = (unsigned)wid * 1024u;
    const int aoff = lds_byte(wr * 64 + fr, fq * 8), boff = lds_byte(wc * 32 + fr, fq * 8);
#define PG8_SA(b, h) (((b) * 2 + (h)) * HTB)
#define PG8_SB(b, h) ((4 + (b) * 2 + (h)) * HTB)
#define PG8_STAGE(bufoff, gbase, voff) do { _Pragma("unroll") for (int _i = 0; _i < 2; ++_i) \
        __builtin_amdgcn_global_load_lds((const unsigned*)((const char*)(gbase) + (voff)[_i]), (LAS unsigned*)(lds + (bufoff) + ldsw + _i * 8192), 16, 0, 0); } while (0)
#define PG8_LDA(dst, b, h) do { _Pragma("unroll") for (int m = 0; m < 4; ++m) _Pragma("unroll") for (int k = 0; k < 2; ++k) dst[m][k] = *(const LAS bf16x8*)(lds + PG8_SA(b, h) + aoff + m * 2048 + k * 1024); } while (0)
#define PG8_LDB(dst, b, h) do { _Pragma("unroll") for (int n = 0; n < 2; ++n) _Pragma("unroll") for (int k = 0; k < 2; ++k) dst[n][k] = *(const LAS bf16x8*)(lds + PG8_SB(b, h) + boff + n * 2048 + k * 1024); } while (0)
#define PG8_MMA(ai, bj, At, Bt) do { __builtin_amdgcn_s_setprio(1); _Pragma("unroll") for (int m = 0; m < 4; ++m) _Pragma("unroll") for (int n = 0; n < 2; ++n) _Pragma("unroll") for (int k = 0; k < 2; ++k) \
        acc[ai][bj][m][n] = __builtin_amdgcn_mfma_f32_16x16x32_bf16(Bt[n][k], At[m][k], acc[ai][bj][m][n], 0, 0, 0); __builtin_amdgcn_s_setprio(0); } while (0)
#ifdef DBG_DRAIN
#define PG8_WAIT_V(n) asm volatile("s_waitcnt vmcnt(0)" ::: "memory")
#else
#define PG8_WAIT_V(n) asm volatile("s_waitcnt vmcnt(" #n ")" ::: "memory")
#endif
#define PG8_WAIT_L(n) asm volatile("s_waitcnt lgkmcnt(" #n ")" ::: "memory")
#define PG8_BAR __builtin_amdgcn_s_barrier()
#define PG8_SCHED __builtin_amdgcn_sched_barrier(0)
    Unit cur, nxt; int ui = 0;
    if (!S.next(0, cur)) return;
    f32x4 acc[2][2][4][2];
#pragma unroll
    for (int a = 0; a < 2; ++a)
#pragma unroll
        for (int b = 0; b < 2; ++b)
#pragma unroll
            for (int m = 0; m < 4; ++m)
#pragma unroll
                for (int n = 0; n < 2; ++n) acc[a][b][m][n] = (f32x4){0.f, 0.f, 0.f, 0.f};
    bf16x8 At[4][2], B0[2][2], B1[2][2];
    const char* cA = cur.A; const char* cB = cur.B;
    PG8_STAGE(PG8_SB(0, 0), cB, voffB); PG8_STAGE(PG8_SB(0, 1), cB + hstepB, voffB); PG8_STAGE(PG8_SA(0, 0), cA, voffA); PG8_STAGE(PG8_SA(0, 1), cA + hstepA, voffA);
    if (wr == 1) PG8_BAR;
    PG8_WAIT_V(2); PG8_BAR;
    PG8_STAGE(PG8_SB(1, 0), cB + kstep, voffB); PG8_STAGE(PG8_SA(1, 0), cA + kstep, voffA); PG8_STAGE(PG8_SB(1, 1), cB + hstepB + kstep, voffB);
    PG8_WAIT_V(6); PG8_BAR;
    for (;;) {
        const bool has_next = S.next(ui + 1, nxt);
        const char* nA = has_next ? nxt.A : cA; const char* nB = has_next ? nxt.B : cB;
        if constexpr (Epi::PRE) { cur.dst = (ui & 1) * 4096; E.pre(cur, tid); }
        int nt = cur.nt; asm volatile("" : "+s"(nt));
        for (int t = 0; t < nt; t += 2) {
            const bool last = (t == nt - 2);
            const char* a1 = cA + (size_t)(t + 1) * kstep;
            const char* a2 = last ? nA : cA + (size_t)(t + 2) * kstep; const char* b2 = last ? nB : cB + (size_t)(t + 2) * kstep;
            const char* a3 = a2 + kstep; const char* b3 = b2 + kstep;
            PG8_LDB(B0, 0, 0); PG8_LDB(B1, 0, 1); PG8_SCHED; PG8_LDA(At, 0, 0); PG8_STAGE(PG8_SA(1, 1), a1 + hstepA, voffA);
            PG8_WAIT_V(8); PG8_WAIT_L(0); PG8_BAR; PG8_MMA(0, 0, At, B0); PG8_MMA(0, 1, At, B1); PG8_BAR; PG8_SCHED;
            PG8_LDA(At, 0, 1); PG8_STAGE(PG8_SB(0, 0), b2, voffB); PG8_STAGE(PG8_SB(0, 1), b2 + hstepB, voffB); PG8_STAGE(PG8_SA(0, 0), a2, voffA);
            PG8_WAIT_V(8); PG8_WAIT_L(0); PG8_BAR; PG8_MMA(1, 0, At, B0); PG8_MMA(1, 1, At, B1); PG8_BAR; PG8_SCHED;
            PG8_LDB(B0, 1, 0); PG8_LDB(B1, 1, 1); PG8_SCHED; PG8_LDA(At, 1, 0); PG8_STAGE(PG8_SA(0, 1), a2 + hstepA, voffA);
            PG8_WAIT_V(8); PG8_WAIT_L(0); PG8_BAR; PG8_MMA(0, 0, At, B0); PG8_MMA(0, 1, At, B1); PG8_BAR; PG8_SCHED;
            PG8_LDA(At, 1, 1); PG8_STAGE(PG8_SB(1, 0), b3, voffB); PG8_STAGE(PG8_SB(1, 1), b3 + hstepB, voffB); PG8_STAGE(PG8_SA(1, 0), a3, voffA);
            PG8_WAIT_V(8); PG8_WAIT_L(0); PG8_BAR; PG8_MMA(1, 0, At, B0); PG8_MMA(1, 1, At, B1); PG8_BAR; PG8_SCHED;
        }
        if (wr == 0) PG8_BAR;
        { int fr_ = fr, fq_ = fq, wr_ = wr, wc_ = wc; asm volatile("" : "+v"(fr_), "+v"(fq_), "+s"(wr_), "+s"(wc_)); E(acc, cur, wr_, wc_, fr_, fq_); }
        if (!has_next) break;
#pragma unroll
        for (int a = 0; a < 2; ++a)
#pragma unroll
            for (int b = 0; b < 2; ++b)
#pragma unroll
                for (int m = 0; m < 4; ++m)
#pragma unroll
                    for (int n = 0; n < 2; ++n) acc[a][b][m][n] = (f32x4){0.f, 0.f, 0.f, 0.f};
        cur = nxt; cA = nA; cB = nB; ++ui;
        if (wr == 1) PG8_BAR;
    }
    PG8_WAIT_V(0);
    PG8_BAR;
#undef PG8_SA
#undef PG8_SB
#undef PG8_STAGE
#undef PG8_LDA
#undef PG8_LDB
#undef PG8_MMA
#undef PG8_WAIT_V
#undef PG8_WAIT_L
#undef PG8_BAR
#undef PG8_SCHED
}
}
using pg8::Unit;
typedef f32x4 Acc[2][2][4][2];

__device__ __forceinline__ u32x4 pack8(const f32x4 v0, const f32x4 v1) { u32x4 w; w.x = cvt_pk_bf16(v0[0], v0[1]); w.y = cvt_pk_bf16(v0[2], v0[3]); w.z = cvt_pk_bf16(v1[0], v1[1]); w.w = cvt_pk_bf16(v1[2], v1[3]); return w; }

__device__ __forceinline__ size_t gate_frag_off(int pm, int gct, int ai, int m, int bj, int wave, int lane) { return ((size_t)(pm * 32 + gct) << 16) + (size_t)(((((ai * 4 + m) * 2 + bj) * 8 + wave) * 64 + lane) * 8); }
struct EpiG1 {
    static constexpr bool PERM = true, PRE = false, APERM = false;
    bf16_t* P; bf16_t* PT; bf16_t* GATES; const float* bgate; const float* ropeC; const float* ropeS; const float* ropeCT; const float* ropeST;
    __device__ __forceinline__ void operator()(const Acc& acc, const Unit& u, int wr, int wc, int fr, int fq) const {
        const int ct0 = wc * 32 + 8 * fq;
        if (u.kind == 0) {
#pragma unroll
            for (int ai = 0; ai < 2; ++ai)
#pragma unroll
                for (int m = 0; m < 4; ++m) { bf16_t* rowp = P + (size_t)(u.r0 + ai * 128 + wr * 64 + m * 16 + fr) * INW + u.dst + ct0;
#pragma unroll
                    for (int bj = 0; bj < 2; ++bj) *(u32x4*)(rowp + bj * 128) = pack8(acc[ai][bj][m][0], acc[ai][bj][m][1]); }
        } else if (u.kind == 2) {
            f32x4 bv[2][2];
#pragma unroll
            for (int bj = 0; bj < 2; ++bj) { bv[bj][0] = *(const f32x4*)(bgate + u.dst + ct0 + bj * 128) * NLOG2E; bv[bj][1] = *(const f32x4*)(bgate + u.dst + ct0 + bj * 128 + 4) * NLOG2E; }
            SCHED_FENCE();
#pragma unroll
            for (int bj = 0; bj < 2; ++bj)
#pragma unroll
                for (int ai = 0; ai < 2; ++ai)
#pragma unroll
                    for (int m = 0; m < 4; ++m) { bf16_t* rowp = GATES + gate_frag_off(u.r0 >> 8, u.dst >> 8, ai, m, bj, wr * 4 + wc, fq * 16 + fr);
                        __builtin_nontemporal_store(pack8(acc[ai][bj][m][0] * NLOG2E + bv[bj][0], acc[ai][bj][m][1] * NLOG2E + bv[bj][1]), (u32x4*)(rowp)); }
        } else if (u.kind == 1) {
            const int s = seq_of_row(u.r0), pos0 = u.r0 - seq_start(s);
            const float sc = (u.c0 != 0) ? 0.08838834764831845f : 1.0f;
            const int hl = wc >> 1, jd0 = 32 * (wc & 1) + 8 * fq;
#pragma unroll
            for (int ai = 0; ai < 2; ++ai) { f32x4 cv[4][2], sv[4][2];
#pragma unroll
                for (int m = 0; m < 4; ++m) { const int pos = pos0 + ai * 128 + wr * 64 + m * 16 + fr;
#pragma unroll
                    for (int n = 0; n < 2; ++n) { cv[m][n] = *(const f32x4*)(ropeC + (size_t)pos * 64 + jd0 + 4 * n); sv[m][n] = *(const f32x4*)(ropeS + (size_t)pos * 64 + jd0 + 4 * n); } }
                SCHED_FENCE();
#pragma unroll
                for (int m = 0; m < 4; ++m) { const int rt = ai * 128 + wr * 64 + m * 16 + fr; bf16_t* rowp = P + (size_t)(u.r0 + rt) * INW + u.dst + hl * 128 + jd0;
#pragma unroll
                    for (int n = 0; n < 2; ++n) { const f32x4 x1 = acc[ai][0][m][n], x2 = acc[ai][1][m][n]; const f32x4 o1 = (x1 * cv[m][n] - x2 * sv[m][n]) * sc, o2 = (x1 * sv[m][n] + x2 * cv[m][n]) * sc;
                        u32x2 w1, w2; w1.x = cvt_pk_bf16(o1[0], o1[1]); w1.y = cvt_pk_bf16(o1[2], o1[3]); w2.x = cvt_pk_bf16(o2[0], o2[1]); w2.y = cvt_pk_bf16(o2[2], o2[3]);
                        *(u32x2*)(rowp + 4 * n) = w1; *(u32x2*)(rowp + 64 + 4 * n) = w2; } }
                SCHED_FENCE(); }
        } else {
#pragma unroll
            for (int ai = 0; ai < 2; ++ai)
#pragma unroll
                for (int m = 0; m < 4; ++m) { bf16_t* rowp = PT + (size_t)(u.dst + ai * 128 + wr * 64 + m * 16 + fr) * MTOK + u.c0 + ct0;
#pragma unroll
                    for (int bj = 0; bj < 2; ++bj) __builtin_nontemporal_store(pack8(acc[ai][bj][m][0], acc[ai][bj][m][1]), (u32x4*)(rowp + bj * 128)); }
        }
    }
};
struct SchedG1 {
    int G, c; const char* H; const char* W1T;
    __device__ __forceinline__ bool next(int i, Unit& u) const {
        int pm, pn; if (!pg8::tile_order(i, G, c, 96, 50, pm, pn)) return false;
        const size_t rowb = 4096;
        u.nt = 32; u.r0 = pm * 256; u.c0 = 0;
        if (pn < 46) {
            u.A = H + (size_t)pm * 256 * rowb;
            if (pn < 14) { u.B = W1T + (size_t)pn * 256 * rowb;
                if (pn >= 4 && pn < 8) { u.kind = 1; u.c0 = (pn >= 6) ? 1 : 0; u.dst = (pn < 6) ? 1024 + (pn - 4) * 256 : 1536 + (pn - 6) * 256; }
                else { u.kind = 0; u.dst = pn < 4 ? pn * 256 : (pn < 10 ? 2560 + (pn - 8) * 256 : (pn < 12 ? 3072 + (pn - 10) * 256 : 3584 + (pn - 12) * 256)); } }
            else { u.B = W1T + (size_t)(4608 + (pn - 14) * 256) * rowb; u.kind = 2; u.dst = (pn - 14) * 256; }
        } else {
            u.B = H + (size_t)pm * 256 * rowb; u.c0 = pm * 256;
            u.A = W1T + (size_t)(3584 + (pn - 46) * 256) * rowb; u.kind = 3; u.dst = 512 + (pn - 46) * 256;
        }
        return true;
    }
};

__device__ __forceinline__ size_t yt_seq_off(int s) { return s < 2 ? (size_t)s * 512 * 64 * 256 : (size_t)2 * 512 * 64 * 256 + (size_t)(s - 2) * 512 * 32 * 256; }
struct EpiCDFT {
    static constexpr bool PERM = false, PRE = false, APERM = false;
    bf16_t* YT;
    __device__ __forceinline__ void operator()(const Acc& acc, const Unit& u, int wr, int wc, int fr, int fq) const {
        const int s = u.kind, N2 = seq_len(s) >> 7; bf16_t* yt = YT + yt_seq_off(s);
#pragma unroll
        for (int m = 0; m < 4; ++m) { const int col = u.dst * 128 + 64 * wr + 16 * m + fr;
#pragma unroll
            for (int bj = 0; bj < 2; ++bj) { bf16_t* rowp = yt + ((size_t)(col * N2 + u.c0 + bj) * 2) * 128 + 32 * wc + 4 * fq;
#pragma unroll
                for (int n = 0; n < 2; ++n) { const f32x4 cv = acc[0][bj][m][n], sv = acc[1][bj][m][n];
                    u32x2 w0, w1; w0.x = cvt_pk_bf16(cv[0], cv[1]); w0.y = cvt_pk_bf16(cv[2], cv[3]); w1.x = cvt_pk_bf16(sv[0], sv[1]); w1.y = cvt_pk_bf16(sv[2], sv[3]);
                    *(u32x2*)(rowp + 16 * n) = w0; *(u32x2*)(rowp + 128 + 16 * n) = w1; } } }
    }
};
struct SchedCDFT {
    int G, c; const char* D2; const char* P; int lng;
    __device__ __forceinline__ bool next(int i, Unit& u) const {
        const int L = i * G + c; int s, bp, g;
        if (lng) { if (L >= 256) return false; s = L >> 7; bp = (L & 127) >> 2; g = L & 3; }
        else { if (L >= 128) return false; s = 2 + (L >> 6); bp = (L & 63) >> 2; g = L & 3; }
        u.A = D2; u.B = P + ((size_t)(seq_start(s) + 2 * bp) * INW + 512 + g * 128) * 2; u.nt = 2; u.kind = s; u.dst = g; u.c0 = 2 * bp; u.r0 = 0; return true;
    }
};
struct EpiF1 {
    static constexpr bool PERM = true, PRE = false, APERM = false;
    bf16_t* ZT; const float* twl; const float* tws;
    __device__ __forceinline__ void operator()(const Acc& acc, const Unit& u, int wr, int wc, int fr, int fq) const {
        const int s = u.kind; const bool lng = s < 2; const int N2 = lng ? 64 : 32, sh = lng ? 6 : 5; const float* tc = lng ? twl : tws; const float* ts = tc + 128 * N2;
        bf16_t* zt = ZT + (size_t)s * 65536 * 128;
#pragma unroll
        for (int mp = 0; mp < 2; ++mp) { f32x4 tcv[2][2][2], tsv[2][2][2];
#pragma unroll
            for (int mm = 0; mm < 2; ++mm) { const int c = 64 * wr + 16 * (2 * mp + mm) + fr;
#pragma unroll
                for (int bj = 0; bj < 2; ++bj) { const int b = (u.c0 + 128 * bj + 32 * wc + 8 * fq) & (N2 - 1);
                    tcv[mm][bj][0] = *(const f32x4*)(tc + c * N2 + b); tcv[mm][bj][1] = *(const f32x4*)(tc + c * N2 + b + 4); tsv[mm][bj][0] = *(const f32x4*)(ts + c * N2 + b); tsv[mm][bj][1] = *(const f32x4*)(ts + c * N2 + b + 4); } }
            SCHED_FENCE();
#pragma unroll
            for (int mm = 0; mm < 2; ++mm) { const int m = 2 * mp + mm, c = 64 * wr + 16 * m + fr;
#pragma unroll
                for (int bj = 0; bj < 2; ++bj) { const int n0 = u.c0 + 128 * bj + 32 * wc + 8 * fq, col = n0 >> sh, b = n0 & (N2 - 1);
                    bf16_t* rowp = zt + ((size_t)c * 512 + col) * 128;
                    const f32x4 c0 = tcv[mm][bj][0], c1 = tcv[mm][bj][1], s0 = tsv[mm][bj][0], s1 = tsv[mm][bj][1];
                    const f32x4 zr0 = acc[0][bj][m][0], zr1 = acc[0][bj][m][1], zi0 = acc[1][bj][m][0], zi1 = acc[1][bj][m][1];
                    *(u32x4*)(rowp + b) = pack8(zr0 * c0 + zi0 * s0, zr1 * c1 + zi1 * s1);
                    *(u32x4*)(rowp + N2 + b) = pack8(zi0 * c0 - zr0 * s0, zi1 * c1 - zr1 * s1);
                    if (!lng) { const u32x4 z = (u32x4){0u, 0u, 0u, 0u}; *(u32x4*)(rowp + 64 + b) = z; *(u32x4*)(rowp + 96 + b) = z; } } }
            SCHED_FENCE(); }
    }
};
struct SchedF1 {
    int G, c; const char* A1; const char* YT;
    __device__ __forceinline__ bool next(int i, Unit& u) const {
        const int L = i * G + c; if (L >= 384) return false; int s, t;
        if (L < 256) { s = L >> 7; t = L & 127; } else { s = 2 + ((L - 256) >> 6); t = (L - 256) & 63; }
        u.A = A1; u.B = YT + yt_seq_off(s) * 2 + (size_t)t * 256 * 512; u.nt = 4; u.kind = s; u.c0 = t * 256; u.r0 = 0; u.dst = 0; return true;
    }
};
struct EpiF2 {
    static constexpr bool PERM = true, PRE = false, APERM = false;
    bf16_t* BR;
    __device__ __forceinline__ void operator()(const Acc& acc, const Unit& u, int wr, int wc, int fr, int fq) const {
        const int s = u.kind; const bool lng = s < 2; const float sc = lng ? 9.765625e-4f : 1.3810679320049757e-3f;
        if (wr != 0) return;
        const int st = seq_start(s);
#pragma unroll
        for (int m = 0; m < 4; ++m) { if (!lng && m >= 2) break; const int d = 16 * m + fr;
#pragma unroll
            for (int bj = 0; bj < 2; ++bj) { const int n0 = u.c0 + 128 * bj + 32 * wc + 8 * fq, c = n0 >> 9, col = n0 & 511;
                *(u32x4*)(BR + (size_t)(st + c + 128 * d) * D + 512 + col) = pack8(acc[0][bj][m][0] * sc, acc[0][bj][m][1] * sc); } }
    }
};
struct SchedF2 {
    int G, c; const char* A2L; const char* A2S; const char* ZT;
    __device__ __forceinline__ bool next(int i, Unit& u) const {
        const int L = i * G + c; if (L >= 1024) return false; const int s = L >> 8, t = L & 255;
        u.A = s < 2 ? A2L : A2S; u.B = ZT + (size_t)s * 65536 * 256 + (size_t)t * 256 * 256; u.nt = 2; u.kind = s; u.c0 = t * 256; u.r0 = 0; u.dst = 0; return true;
    }
};
__device__ __forceinline__ u32x4 ldg16_raw(const void* p) { u32x4 v; asm volatile("global_load_dwordx4 %0, %1, off" : "=v"(v) : "v"(p) : "memory"); return v; }
__device__ __forceinline__ u32x4 ldg16_so(const void* base, unsigned off) { u32x4 v; asm volatile("global_load_dwordx4 %0, %1, %2" : "=v"(v) : "v"(off), "s"(base) : "memory"); return v; }
__device__ __forceinline__ u32x4 ldg16_so_nt(const void* base, unsigned off) { u32x4 v; asm volatile("global_load_dwordx4 %0, %1, %2 nt" : "=v"(v) : "v"(off), "s"(base) : "memory"); return v; }
__device__ __forceinline__ u32x4 ldg16_raw256(const void* p) { u32x4 v; asm volatile("global_load_dwordx4 %0, %1, off offset:256" : "=v"(v) : "v"(p) : "memory"); return v; }
#define VM_WAIT(n) asm volatile("s_waitcnt vmcnt(" #n ")" ::: "memory")
#define VM_USE8(a, b, c, d, e, f, g, h) asm volatile("" : "+v"(a), "+v"(b), "+v"(c), "+v"(d), "+v"(e), "+v"(f), "+v"(g), "+v"(h))
struct EpiMerge {
    static constexpr bool PERM = true, PRE = false, APERM = false;
    bf16_t* MERGED; const bf16_t* GATES; const bf16_t* ZERO;
    __device__ __forceinline__ void ld(u32x4 (&gv)[2][2], u32x4 (&ov)[2][2], const Unit& u, int step, unsigned gvo, unsigned ovo) const {
        const int b = u.kind, ai = step >> 1;
        const bf16_t* gt = GATES + ((size_t)((u.r0 >> 8) * 32 + b * 8 + (u.c0 >> 8)) << 16);
        const bf16_t* ot = (b != 0) ? MERGED + (size_t)u.r0 * D + u.c0 : ZERO;
#pragma unroll
        for (int mm = 0; mm < 2; ++mm) { const int m = (step & 1) * 2 + mm;
            gv[mm][0] = ldg16_so_nt(gt + (((ai * 4 + m) * 2 + 0) * 8) * 512, gvo); gv[mm][1] = ldg16_so_nt(gt + (((ai * 4 + m) * 2 + 1) * 8) * 512, gvo);
            const bf16_t* orow = (b != 0) ? ot + (size_t)(ai * 128 + m * 16) * D : ot;
            ov[mm][0] = ldg16_so(orow, ovo); ov[mm][1] = ldg16_so(orow + 128, ovo); }
    }
    __device__ __forceinline__ void operator()(const Acc& acc, const Unit& u, int wr, int wc, int fr, int fq) const {
        const int ct0 = wc * 32 + 8 * fq;
        u32x4 gv[2][2][2], ov[2][2][2];
        const unsigned gvo = (unsigned)(((wr * 4 + wc) * 64 + fq * 16 + fr) * 16), ovo = (u.kind != 0) ? (unsigned)(((wr * 64 + fr) * D + ct0) * 2) : (unsigned)(ct0 * 2);
        ld(gv[0], ov[0], u, 0, gvo, ovo); ld(gv[1], ov[1], u, 1, gvo, ovo);
        SCHED_FENCE();
#pragma unroll
        for (int step = 0; step < 4; ++step) { const int ai = step >> 1, st = step & 1;
            if (step == 0 || step == 3) VM_WAIT(8); else if (step == 1) VM_WAIT(12); else VM_WAIT(16);
            VM_USE8(gv[st][0][0], gv[st][0][1], gv[st][1][0], gv[st][1][1], ov[st][0][0], ov[st][0][1], ov[st][1][0], ov[st][1][1]);
            SCHED_FENCE();
            u32x4 res[2][2];
#pragma unroll
            for (int mm = 0; mm < 2; ++mm) { const int m = st * 2 + mm;
#pragma unroll
                for (int bj = 0; bj < 2; ++bj) { const u32x4 g = gv[st][mm][bj], o = ov[st][mm][bj]; f32x4 v0 = acc[ai][bj][m][0], v1 = acc[ai][bj][m][1];
                    v0[0] = v0[0] * sig2_(bflo(g.x)) + bflo(o.x); v0[1] = v0[1] * sig2_(bfhi(g.x)) + bfhi(o.x); v0[2] = v0[2] * sig2_(bflo(g.y)) + bflo(o.y); v0[3] = v0[3] * sig2_(bfhi(g.y)) + bfhi(o.y);
                    v1[0] = v1[0] * sig2_(bflo(g.z)) + bflo(o.z); v1[1] = v1[1] * sig2_(bfhi(g.z)) + bfhi(o.z); v1[2] = v1[2] * sig2_(bflo(g.w)) + bflo(o.w); v1[3] = v1[3] * sig2_(bfhi(g.w)) + bfhi(o.w);
                    res[mm][bj] = pack8(v0, v1); } }
            SCHED_FENCE();
            if (step < 2) { ld(gv[st], ov[st], u, step + 2, gvo, ovo); SCHED_FENCE(); }
#pragma unroll
            for (int mm = 0; mm < 2; ++mm) { bf16_t* rowp = MERGED + (size_t)(u.r0 + ai * 128 + wr * 64 + (st * 2 + mm) * 16 + fr) * D + u.c0 + ct0;
#pragma unroll
                for (int bj = 0; bj < 2; ++bj) *(u32x4*)(rowp + bj * 128) = res[mm][bj]; }
            SCHED_FENCE(); }
    }
};
struct SchedMerge {
    int G, c; const char* BR; const char* WBRT;
    __device__ __forceinline__ bool next(int i, Unit& u) const {
        int pm, pn; if (!pg8::tile_order(i >> 2, G, c, 96, 8, pm, pn)) return false; const int b = i & 3;
        u.A = BR + (size_t)pm * 256 * 4096 + (size_t)b * 1024; u.B = WBRT + (size_t)b * (2048 * 1024) + (size_t)pn * 256 * 1024; u.nt = 8; u.kind = b; u.r0 = pm * 256; u.c0 = pn * 256; u.dst = 0; return true;
    }
};
template <int OFF> __device__ __forceinline__ f32x4 ldg16f_raw(const void* p) { f32x4 v; asm volatile("global_load_dwordx4 %0, %1, off offset:%2" : "=v"(v) : "v"(p), "n"(OFF) : "memory"); return v; }
#define VM_USE4(a, b, c, d) asm volatile("" : "+v"(a), "+v"(b), "+v"(c), "+v"(d))
struct EpiRes {
    static constexpr bool PERM = true, PRE = false, APERM = false;
    bf16_t* xb; const float* gate;
    __device__ __forceinline__ void ld(u32x4 (&xv)[2][2], const Unit& u, int step, int wr, int fr, int ct0) const {
#pragma unroll
        for (int mm = 0; mm < 2; ++mm) { const bf16_t* p = xb + (size_t)(u.r0 + (step >> 1) * 128 + wr * 64 + ((step & 1) * 2 + mm) * 16 + fr) * D + u.c0 + ct0;
            xv[mm][0] = ldg16_raw(p); xv[mm][1] = ldg16_raw256(p); }
    }
    __device__ __forceinline__ void operator()(const Acc& acc, const Unit& u, int wr, int wc, int fr, int fq) const {
        const int s = seq_of_row(u.r0); const int ct0 = wc * 32 + 8 * fq; const float* gv = gate + (size_t)s * 12288 + u.c0 + ct0;
        f32x4 g8[2][2]; u32x4 xv[2][2][2];
        g8[0][0] = ldg16f_raw<0>(gv); g8[0][1] = ldg16f_raw<16>(gv); g8[1][0] = ldg16f_raw<512>(gv); g8[1][1] = ldg16f_raw<528>(gv);
        ld(xv[0], u, 0, wr, fr, ct0); ld(xv[1], u, 1, wr, fr, ct0);
        SCHED_FENCE();
#pragma unroll
        for (int step = 0; step < 4; ++step) { const int ai = step >> 1, st = step & 1;
            if (step == 0) VM_WAIT(4); else if (step == 2) VM_WAIT(12); else VM_WAIT(8);
            if (step == 0) VM_USE4(g8[0][0], g8[0][1], g8[1][0], g8[1][1]);
            VM_USE4(xv[st][0][0], xv[st][0][1], xv[st][1][0], xv[st][1][1]);
            SCHED_FENCE();
            u32x4 res[2][2];
#pragma unroll
            for (int mm = 0; mm < 2; ++mm)
#pragma unroll
                for (int bj = 0; bj < 2; ++bj) { const u32x4 o = xv[st][mm][bj]; const int m = st * 2 + mm;
                    const f32x4 x0 = {bflo(o.x), bfhi(o.x), bflo(o.y), bfhi(o.y)}, x1 = {bflo(o.z), bfhi(o.z), bflo(o.w), bfhi(o.w)};
                    res[mm][bj] = pack8(x0 + g8[bj][0] * acc[ai][bj][m][0], x1 + g8[bj][1] * acc[ai][bj][m][1]); }
            SCHED_FENCE();
            if (step < 2) { ld(xv[st], u, step + 2, wr, fr, ct0); SCHED_FENCE(); }
#pragma unroll
            for (int mm = 0; mm < 2; ++mm) { bf16_t* rowp = xb + (size_t)(u.r0 + ai * 128 + wr * 64 + (st * 2 + mm) * 16 + fr) * D + u.c0 + ct0;
#pragma unroll
                for (int bj = 0; bj < 2; ++bj) *(u32x4*)(rowp + bj * 128) = res[mm][bj]; }
            SCHED_FENCE(); }
    }
};
struct SchedPlain {
    int G, c; const char* A; const char* B; int nN, nt; size_t rowb;
    __device__ __forceinline__ bool next(int i, Unit& u) const {
        int pm, pn; if (!pg8::tile_order(i, G, c, 96, nN, pm, pn)) return false;
        u.A = A + (size_t)pm * 256 * rowb; u.B = B + (size_t)pn * 256 * rowb; u.nt = nt; u.kind = 0; u.r0 = pm * 256; u.c0 = pn * 256; u.dst = 0; return true;
    }
};
struct EpiUpConv {
    static constexpr bool PERM = true, PRE = true, APERM = true;
    bf16_t* ACT; bf16_t* YB; const float* cw; const float* cb; LAS unsigned char* scr;
    __device__ __forceinline__ void pre(const Unit& u, int tid) const {
        const int kind = tid >> 7, ch = (u.c0 >> 1) + (tid & 127);
        const float* s0 = (kind < 3) ? cw + (size_t)kind * NUP + ch : cb + ch;
        LAS unsigned char* d = scr + u.dst + __builtin_amdgcn_readfirstlane(tid >> 6) * 256;
        __builtin_amdgcn_global_load_lds((const unsigned*)s0, (LAS unsigned*)d, 4, 0, 0);
        __builtin_amdgcn_global_load_lds((const unsigned*)(s0 + DFF), (LAS unsigned*)(d + 2048), 4, 0, 0);
    }
    __device__ __forceinline__ void operator()(const Acc& acc, const Unit& u, int wr, int wc, int fr, int fq) const {
        const int chl0 = 32 * wc + 8 * fq, chan0 = (u.c0 >> 1) + chl0;
        const LAS unsigned char* wl = scr + u.dst;
#pragma unroll
        for (int ai = 0; ai < 2; ++ai) { const int row0 = u.r0 + ai * 128 + wr * 64 + 4 * fr; unsigned w0[4][2];
#pragma unroll
            for (int n = 0; n < 2; ++n) { unsigned wv[4];
#pragma unroll
                for (int ep = 0; ep < 2; ++ep) { const int e0 = 2 * ep; const LAS unsigned char* wp = wl + (chl0 + 4 * n + e0) * 4;
                    const f32x2 a0p = *(const LAS f32x2*)(wp), a1p = *(const LAS f32x2*)(wp + 512), a2p = *(const LAS f32x2*)(wp + 1024), abp = *(const LAS f32x2*)(wp + 1536);
                    const f32x2 b0p = *(const LAS f32x2*)(wp + 2048), b1p = *(const LAS f32x2*)(wp + 2560), b2p = *(const LAS f32x2*)(wp + 3072), bbp = *(const LAS f32x2*)(wp + 3584);
                    f32x2 y[2][4];
#pragma unroll
                    for (int bj = 0; bj < 2; ++bj)
#pragma unroll
                        for (int m = 0; m < 4; ++m) y[bj][m] = (f32x2){acc[ai][bj][m][n][e0], acc[ai][bj][m][n][e0 + 1]};
                    const f32x2 pa0 = {dpp_ror1(y[0][3].x), dpp_ror1(y[0][3].y)}, na3 = {dpp_ror15(y[0][0].x), dpp_ror15(y[0][0].y)};
                    const f32x2 pb0 = {dpp_ror1(y[1][3].x), dpp_ror1(y[1][3].y)}, nb3 = {dpp_ror15(y[1][0].x), dpp_ror15(y[1][0].y)};
                    f32x2 ua[4], ub[4], ex[4];
#pragma unroll
                    for (int m = 0; m < 4; ++m) {
                        const f32x2 pa = m > 0 ? y[0][m > 0 ? m - 1 : 0] : pa0, na = m < 3 ? y[0][m < 3 ? m + 1 : 3] : na3;
                        const f32x2 pb = m > 0 ? y[1][m > 0 ? m - 1 : 0] : pb0, nb = m < 3 ? y[1][m < 3 ? m + 1 : 3] : nb3;
                        ua[m] = a0p * pa + (a1p * y[0][m] + (a2p * na + abp)); ub[m] = b0p * pb + (b1p * y[1][m] + (b2p * nb + bbp));
                        const f32x2 q = ua[m] * (ua[m] * ua[m] * 0.10294324f + 2.3022082f);
                        ex[m].x = __builtin_amdgcn_exp2f(q.x); ex[m].y = __builtin_amdgcn_exp2f(q.y); }
                    SCHED_FENCE();
#pragma unroll
                    for (int m = 0; m < 4; ++m) { ex[m] = ex[m] + 1.0f; ex[m].x = fast_rcp(ex[m].x); ex[m].y = fast_rcp(ex[m].y); }
                    SCHED_FENCE();
#pragma unroll
                    for (int m = 0; m < 4; ++m) { const f32x2 o = (ua[m] - ua[m] * ex[m]) * ub[m];
                        const unsigned wn = cvt_pk_bf16(o.x, o.y);
                        if (ep == 0) wv[m] = wn;
                        else if (n == 0) { w0[m][0] = wv[m]; w0[m][1] = wn; }
                        else { u32x4 w; w.x = w0[m][0]; w.y = w0[m][1]; w.z = wv[m]; w.w = wn;
                            *(u32x4*)(ACT + (size_t)(row0 + m) * DFF + chan0) = w; } } } }
            SCHED_FENCE(); }
        if (fr == 0 || fr == 15) {
#pragma unroll
            for (int ai = 0; ai < 2; ++ai) { const int blk = (u.r0 + ai * 128 + wr * 64) >> 6;
#pragma unroll
                for (int j = 0; j < 2; ++j) { bf16_t* yp = YB + ((size_t)blk * 4 + (fr == 0 ? j : 2 + j)) * NUP + chan0;
#pragma unroll
                    for (int bj = 0; bj < 2; ++bj) { const f32x4 v0 = (fr == 0) ? acc[ai][bj][j][0] : acc[ai][bj][2 + j][0], v1 = (fr == 0) ? acc[ai][bj][j][1] : acc[ai][bj][2 + j][1];
                        *(u32x4*)(yp + bj * DFF) = pack8(v0, v1); } } } }
    }
};

struct Args { const float* in[23]; float* out; unsigned char* ws; int ph_lo, ph_hi; };
struct Frame {
    LAS unsigned char* lds; int tid, lane, wave, G, gw, NGW, bid;
    float* out; unsigned char* ws;
};
#define LDS_WAIT() asm volatile("s_waitcnt lgkmcnt(0)" ::: "memory")

__device__ __forceinline__ void transpose_item(const float* W, int K, int N, bf16_t* WT, int drow, int k0, int n0, LAS float* scr, int lane) {
    (void)scr; const int kq = lane >> 3, n4 = lane & 7;
    f32x4 tv[8];
#pragma unroll
    for (int i = 0; i < 8; ++i) tv[i] = *(const f32x4*)(W + (size_t)(k0 + 8 * kq + i) * N + n0 + 4 * n4);
#pragma unroll
    for (int e = 0; e < 4; ++e) { u32x4 o; o.x = cvt_pk_bf16(tv[0][e], tv[1][e]); o.y = cvt_pk_bf16(tv[2][e], tv[3][e]); o.z = cvt_pk_bf16(tv[4][e], tv[5][e]); o.w = cvt_pk_bf16(tv[6][e], tv[7][e]);
        *(u32x4*)(WT + (size_t)(drow + 4 * n4 + e) * K + k0 + 8 * kq) = o; }
}
__device__ __forceinline__ int map_in(int n0) {
    if (n0 < 1024) return n0;
    if (n0 < 2048) { const int off = n0 - 1024, which = off >> 9, hh = (off & 511) >> 7, d = off & 127, half = d >> 6, jd = d & 63; return 1024 + which * 512 + (hh >> 1) * 256 + half * 128 + (hh & 1) * 64 + jd; }
    if (n0 < 2560) return 3584 + (n0 - 2048);
    if (n0 < 3072) return 2048 + (n0 - 2560);
    if (n0 < 3584) return 2560 + (n0 - 3072);
    if (n0 < 4096) return 3072 + (n0 - 3584);
    return n0;
}
constexpr int CV_IN = (D / 64) * (INW / 32), CV_G = (D / 64) * (NGATE / 32), CV_BR = (512 / 64) * (D / 32), CV_OUT = (D / 64) * (D / 32), CV_UP = (D / 64) * (NUP / 32), CV_DN = (DFF / 64) * (D / 32);
constexpr int CV_A = CV_IN + CV_G + 3 * CV_BR + CV_OUT, CV_N = CV_A + CV_UP + CV_DN;
constexpr int CV_QG1 = 5120, CV_QUP = 10240;
__device__ __forceinline__ void convert_span(Frame& F, int l, const float* w_in0, const float* w_gate0, const float* w_branch0, const float* w_out0, const float* w_up0, const float* w_down0, int lo1, int len1, int lo2, int len2, int w0, int nw) {
    const float* w_in = w_in0 + (size_t)l * D * INW; const float* w_gate = w_gate0 + (size_t)l * D * NGATE; const float* w_branch = w_branch0 + (size_t)l * 4 * 512 * D;
    const float* w_out = w_out0 + (size_t)l * D * D; const float* w_up = w_up0 + (size_t)l * D * NUP; const float* w_down = w_down0 + (size_t)l * DFF * D;
    bf16_t* W1T = (bf16_t*)(F.ws + WS_W1T); bf16_t* WBRT = (bf16_t*)(F.ws + WS_WBRT); bf16_t* WOUTT = (bf16_t*)(F.ws + WS_WOUTT); bf16_t* WUPT = (bf16_t*)(F.ws + WS_WUPT); bf16_t* WDNT = (bf16_t*)(F.ws + WS_WDNT);
    LAS float* scr = nullptr;
    for (int v = w0; v < len1 + len2; v += nw) {
        int r = v < len1 ? lo1 + v : lo2 + (v - len1);
        if (r < CV_IN) { const int nb = INW / 32, kb = r / nb, n0 = (r % nb) * 32; transpose_item(w_in, D, INW, W1T, map_in(n0), kb * 64, n0, scr, F.lane); continue; } r -= CV_IN;
        if (r < CV_G) { const int nb = NGATE / 32, kb = r / nb, n0 = (r % nb) * 32; transpose_item(w_gate, D, NGATE, W1T, 4608 + n0, kb * 64, n0, scr, F.lane); continue; } r -= CV_G;
        if (r < 3 * CV_BR) { const int b = 1 + r / CV_BR, rr = r % CV_BR, nb = D / 32, kb = rr / nb, n0 = (rr % nb) * 32; transpose_item(w_branch + (size_t)b * 512 * D, 512, D, WBRT + (size_t)b * D * 512, n0, kb * 64, n0, scr, F.lane); continue; } r -= 3 * CV_BR;
        if (r < CV_OUT) { const int nb = D / 32, kb = r / nb, n0 = (r % nb) * 32; transpose_item(w_out, D, D, WOUTT, n0, kb * 64, n0, scr, F.lane); continue; } r -= CV_OUT;
        if (r < CV_UP) { const int nb = NUP / 32, kb = r / nb, n0 = (r % nb) * 32; transpose_item(w_up, D, NUP, WUPT, (n0 < DFF ? (n0 >> 7) * 256 + (n0 & 127) : ((n0 - DFF) >> 7) * 256 + 128 + ((n0 - DFF) & 127)), kb * 64, n0, scr, F.lane); continue; } r -= CV_UP;
        { const int nb = D / 32, kb = r / nb, n0 = (r % nb) * 32; transpose_item(w_down, DFF, D, WDNT, n0, kb * 64, n0, scr, F.lane); }
    }
}
__device__ __forceinline__ void convert_tail(Frame& F, int l, const float* w_in0, const float* w_gate0, const float* w_branch0, const float* w_out0, const float* w_up0, const float* w_down0, int nwg, int lo, int len) {
    const int rem = nwg % F.G; if (rem != 0 && F.bid < rem) return;
    const int nidle = rem ? F.G - rem : F.G, rank = rem ? F.bid - rem : F.bid;
    convert_span(F, l, w_in0, w_gate0, w_branch0, w_out0, w_up0, w_down0, lo, len, 0, 0, rank * NWAVES + F.wave, nidle * NWAVES);
}
__device__ __forceinline__ void convert_weights(Frame& F, int l, const float* w_in0, const float* w_gate0, const float* w_branch0, const float* w_out0, const float* w_up0, const float* w_down0, const float* pool_w0, const float* pool_scale0, bool skip_up) {
    const int q = skip_up ? CV_QUP : 0;
    convert_span(F, l, w_in0, w_gate0, w_branch0, w_out0, w_up0, w_down0, q, CV_A - q, CV_A + CV_QG1, CV_N - CV_A - CV_QG1, F.gw, F.NGW);
    const float* w_branch = w_branch0 + (size_t)l * 4 * 512 * D; bf16_t* WBRT = (bf16_t*)(F.ws + WS_WBRT);
    const float* pw = pool_w0 + (size_t)l * 4 * 128 * 128; const float* ps = pool_scale0 + (size_t)l * 512;
    for (int item = F.bid; item < 256; item += F.G) {
        const int g = item >> 6, ns = (item >> 3) & 7, c0 = (item & 7) * 16 + 2 * F.wave, n0 = ns * 256 + 4 * F.lane;
        float cf[2][2];
#pragma unroll
        for (int j = 0; j < 2; ++j)
#pragma unroll
            for (int h = 0; h < 2; ++h) cf[j][h] = pw[((size_t)g * 128 + c0 + j) * 128 + 64 * h + F.lane] * ps[g * 128 + 64 * h + F.lane];
        const float* wb = w_branch + (size_t)(g * 128) * D + n0;
        f32x4 a0 = (f32x4){0.f, 0.f, 0.f, 0.f}, a1 = a0;
#pragma unroll
        for (int h = 0; h < 2; ++h)
#pragma unroll 16
            for (int el = 0; el < 64; ++el) { const f32x4 w = *(const f32x4*)(wb + (size_t)(64 * h + el) * D);
                const float k0 = __builtin_bit_cast(float, __builtin_amdgcn_readlane(__builtin_bit_cast(int, cf[0][h]), el)), k1 = __builtin_bit_cast(float, __builtin_amdgcn_readlane(__builtin_bit_cast(int, cf[1][h]), el));
                a0 += w * k0; a1 += w * k1; }
        const int k = g * 128 + c0;
#pragma unroll
        for (int j = 0; j < 4; ++j) *(unsigned*)(WBRT + (size_t)(n0 + j) * 512 + k) = cvt_pk_bf16(a0[j], a1[j]);
    }
}
__device__ __forceinline__ void prologue_tables(Frame& F) {
    float* rc = (float*)(F.ws + WS_ROPEC); float* rs = (float*)(F.ws + WS_ROPES);
    const int gt = F.bid * NTHREADS + F.tid, NGT = F.G * NTHREADS;
    for (int it = gt; it < 8192 * 64; it += NGT) { const int pos = it >> 6, j = it & 63;
        const float inv = __builtin_amdgcn_exp2f(-(float)j * (13.287712379549449f / 64.0f)); const float ang = (float)pos * inv;
        const double rev = (double)ang * 0.15915494309189535; const float fr = (float)(rev - floor(rev));
        const float cv = __builtin_amdgcn_cosf(fr), sv = __builtin_amdgcn_sinf(fr);
        rc[it] = cv; rs[it] = sv; }
    bf16_t* d2 = (bf16_t*)(F.ws + WS_D2);
    for (int it = gt; it < 256 * 128; it += NGT) { const int r = it >> 7, c = it & 127, s = r >> 7, kc = r & 127; const float fr = (float)((c * kc) & 127) * (1.0f / 128.0f);
        const float v = s ? __builtin_amdgcn_sinf(fr) : __builtin_amdgcn_cosf(fr); d2[it] = (bf16_t)(cvt_pk_bf16(v, 0.f) & 0xffffu); }
    bf16_t* a1 = (bf16_t*)(F.ws + WS_A1);
    for (int it = gt; it < 256 * 256; it += NGT) { const int r = it >> 8, k = it & 255, pp = r >> 7, c = r & 127, p = k >> 7, a = k & 127; const float fr = (float)((a * c) & 127) * (1.0f / 128.0f);
        const float cv = __builtin_amdgcn_cosf(fr), sv = __builtin_amdgcn_sinf(fr); const float v = (pp == 0) ? (p == 0 ? cv : -sv) : (p == 0 ? -sv : -cv); a1[it] = (bf16_t)(cvt_pk_bf16(v, 0.f) & 0xffffu); }
    bf16_t* a2l = (bf16_t*)(F.ws + WS_A2L); bf16_t* a2s = (bf16_t*)(F.ws + WS_A2S);
    for (int it = gt; it < 256 * 128; it += NGT) { const int d = it >> 7, k = it & 127;
        { const int p = k >> 6, b = k & 63; const float fr = (float)((b * d) & 63) * (1.0f / 64.0f); const float v = d < 64 ? (p ? __builtin_amdgcn_sinf(fr) : __builtin_amdgcn_cosf(fr)) : 0.f; a2l[it] = (bf16_t)(cvt_pk_bf16(v, 0.f) & 0xffffu); }
        { const int p = (k >> 5) & 1, b = k & 31; const float fr = (float)((b * d) & 31) * (1.0f / 32.0f); const float v = (d < 32 && k < 64) ? (p ? __builtin_amdgcn_sinf(fr) : __builtin_amdgcn_cosf(fr)) : 0.f; a2s[it] = (bf16_t)(cvt_pk_bf16(v, 0.f) & 0xffffu); } }
    float* twl = (float*)(F.ws + WS_TWL); float* tws = (float*)(F.ws + WS_TWS);
    for (int it = gt; it < 128 * 64; it += NGT) { const int c = it >> 6, b = it & 63; const float fr = (float)(b * c) * (1.0f / 8192.0f); twl[it] = __builtin_amdgcn_cosf(fr); twl[128 * 64 + it] = __builtin_amdgcn_sinf(fr); }
    for (int it = gt; it < 128 * 32; it += NGT) { const int c = it >> 5, b = it & 31; const float fr = (float)(b * c) * (1.0f / 4096.0f); tws[it] = __builtin_amdgcn_cosf(fr); tws[128 * 32 + it] = __builtin_amdgcn_sinf(fr); }
}
__device__ __forceinline__ void prologue_mod_partial(Frame& F, const float* c_prompt, const float* c_sample, const float* w_ada) {
    LAS float* sc = (LAS float*)F.lds;
    for (int i = F.tid; i < 4 * D; i += NTHREADS) { const int s = i >> 11, k = i & (D - 1); const float v = (s < 2 ? c_prompt : c_sample)[(s & 1) * D + k]; sc[i] = v * sigmoidf_(v); }
    __syncthreads();
    float* modp = (float*)(F.ws + WS_MODP);
    const int kq = F.tid >> 7, n4 = (F.tid & 127) * 4;
    for (int it = F.bid; it < DEPTH * 24 * 8; it += F.G) { const int l = it / 192, nb = (it % 192) >> 3, kp = it & 7; const int n = nb * 512 + n4, kbase = kp * 256 + kq * 64;
        const float* w = w_ada + ((size_t)l * D + kbase) * 12288 + n; f32x4 a0 = (f32x4){0.f, 0.f, 0.f, 0.f}, a1 = a0, a2 = a0, a3 = a0;
#pragma unroll 16
        for (int k = 0; k < 64; ++k) { const f32x4 wv = *(const f32x4*)(w + (size_t)k * 12288); const int kk = kbase + k; a0 += wv * sc[kk]; a1 += wv * sc[D + kk]; a2 += wv * sc[2 * D + kk]; a3 += wv * sc[3 * D + kk]; }
        float* o = modp + ((size_t)((kp * 4 + kq) * DEPTH + l) * 4) * 12288 + n; *(f32x4*)o = a0; *(f32x4*)(o + 12288) = a1; *(f32x4*)(o + 2 * 12288) = a2; *(f32x4*)(o + 3 * 12288) = a3; }
    __syncthreads();
}
__device__ __forceinline__ void prologue_mod_reduce(Frame& F, const float* b_ada) {
    const float* modp = (const float*)(F.ws + WS_MODP); float* mod = (float*)(F.ws + WS_MOD);
    for (int it = F.bid * NTHREADS + F.tid; it < DEPTH * 4 * 12288; it += F.G * NTHREADS) { const int n = it % 12288, l = it / (4 * 12288);
        float a = b_ada[(size_t)l * 12288 + n];
#pragma unroll
        for (int kp = 0; kp < 32; ++kp) a += modp[(size_t)kp * DEPTH * 4 * 12288 + it];
        mod[it] = a; }
}
__device__ __forceinline__ void unpack_row(const u32x4 (&w)[4], f32x4 (&v)[8]) {
#pragma unroll
    for (int j = 0; j < 4; ++j) { v[2 * j] = (f32x4){bflo(w[j].x), bfhi(w[j].x), bflo(w[j].y), bfhi(w[j].y)}; v[2 * j + 1] = (f32x4){bflo(w[j].z), bfhi(w[j].z), bflo(w[j].w), bfhi(w[j].w)}; }
}
__device__ __forceinline__ float sumsq8(const f32x4 (&v)[8]) { float s = 0.f;
#pragma unroll
    for (int j = 0; j < 8; ++j) s += (v[j].x * v[j].x + v[j].y * v[j].y) + (v[j].z * v[j].z + v[j].w * v[j].w);
    return s; }
template <bool SEED>
__device__ __forceinline__ void norm_phase(Frame& F, const float* xp, const float* xs, const float* g, const float* mod_l, int shift_off, int scale_off) {
    bf16_t* H = (bf16_t*)(F.ws + WS_H); bf16_t* XB = (bf16_t*)(F.ws + WS_XB);
    constexpr int RB = SEED ? 2 : 4;
    const int per = 4 * ((MTOK / 4 + F.NGW - 1) / F.NGW), m0 = F.gw * per;
    int cs = -1; f32x4 gs[8], hv[8];
#pragma unroll 1
    for (int i = 0; i < per; i += RB) {
        const int m = m0 + i; if (m >= MTOK) break; const int s = seq_of_row(m);
        if (s != cs) { cs = s; const float* sh = mod_l + (size_t)s * 12288 + shift_off; const float* scl = mod_l + (size_t)s * 12288 + scale_off;
            f32x4 gg[8], sv[8];
#pragma unroll
            for (int j = 0; j < 8; ++j) { const int c = SEED ? 4 * F.lane + 256 * j : 8 * F.lane + 512 * (j >> 1) + 4 * (j & 1); gg[j] = *(const f32x4*)(g + c); sv[j] = *(const f32x4*)(scl + c); hv[j] = *(const f32x4*)(sh + c); }
            SCHED_FENCE();
#pragma unroll
            for (int j = 0; j < 8; ++j) gs[j] = gg[j] * (sv[j] + 1.0f); }
        if (SEED) { f32x4 v0[8], v1[8];
            const float* x0 = (m < 16384 ? xp : xs) + (size_t)m * D; const float* x1 = x0 + D;
#pragma unroll
            for (int j = 0; j < 8; ++j) { v0[j] = *(const f32x4*)(x0 + 4 * F.lane + 256 * j); v1[j] = *(const f32x4*)(x1 + 4 * F.lane + 256 * j); }
#pragma unroll
            for (int j = 0; j < 8; ++j) { const int c = 4 * F.lane + 256 * j; u32x2 w0, w1; w0.x = cvt_pk_bf16(v0[j].x, v0[j].y); w0.y = cvt_pk_bf16(v0[j].z, v0[j].w); w1.x = cvt_pk_bf16(v1[j].x, v1[j].y); w1.y = cvt_pk_bf16(v1[j].z, v1[j].w);
                *(u32x2*)(XB + (size_t)m * D + c) = w0; *(u32x2*)(XB + (size_t)(m + 1) * D + c) = w1; }
            const float r0 = __builtin_amdgcn_rsqf(wave_sum(sumsq8(v0)) * (1.0f / D) + EPS), r1 = __builtin_amdgcn_rsqf(wave_sum(sumsq8(v1)) * (1.0f / D) + EPS);
#pragma unroll
            for (int j = 0; j < 8; ++j) { const int c = 4 * F.lane + 256 * j; const f32x4 y0 = v0[j] * r0 * gs[j] + hv[j], y1 = v1[j] * r1 * gs[j] + hv[j];
                u32x2 w0, w1; w0.x = cvt_pk_bf16(y0.x, y0.y); w0.y = cvt_pk_bf16(y0.z, y0.w); w1.x = cvt_pk_bf16(y1.x, y1.y); w1.y = cvt_pk_bf16(y1.z, y1.w);
                *(u32x2*)(H + (size_t)m * D + c) = w0; *(u32x2*)(H + (size_t)(m + 1) * D + c) = w1; } }
        else { const bf16_t* b0 = XB + (size_t)m * D + 8 * F.lane; u32x4 w[4][4];
#pragma unroll
            for (int rr = 0; rr < 4; ++rr)
#pragma unroll
                for (int j = 0; j < 4; ++j) w[rr][j] = *(const u32x4*)(b0 + (size_t)rr * D + 512 * j);
            SCHED_FENCE();
#pragma unroll
            for (int rr = 0; rr < 4; ++rr) { f32x4 v[8]; unpack_row(w[rr], v);
                const float r = __builtin_amdgcn_rsqf(wave_sum(sumsq8(v)) * (1.0f / D) + EPS);
#pragma unroll
                for (int j = 0; j < 4; ++j) *(u32x4*)(H + (size_t)(m + rr) * D + 8 * F.lane + 512 * j) = pack8(v[2 * j] * r * gs[2 * j] + hv[2 * j], v[2 * j + 1] * r * gs[2 * j + 1] + hv[2 * j + 1]); } }
    }
}
__device__ __forceinline__ void final_norm_phase(Frame& F, const float* g_final) {
    const bf16_t* XB = (const bf16_t*)(F.ws + WS_XB);
    const int per = 4 * ((MTOK / 4 + F.NGW - 1) / F.NGW), m0 = F.gw * per;
    f32x4 gg[8];
#pragma unroll
    for (int j = 0; j < 8; ++j) gg[j] = *(const f32x4*)(g_final + 8 * F.lane + 512 * (j >> 1) + 4 * (j & 1));
#pragma unroll 1
    for (int i = 0; i < per; i += 4) { const int m = m0 + i; if (m >= MTOK) break;
        const bf16_t* b0 = XB + (size_t)m * D + 8 * F.lane; u32x4 w[4][4];
#pragma unroll
        for (int rr = 0; rr < 4; ++rr)
#pragma unroll
            for (int j = 0; j < 4; ++j) w[rr][j] = *(const u32x4*)(b0 + (size_t)rr * D + 512 * j);
        SCHED_FENCE();
#pragma unroll
        for (int rr = 0; rr < 4; ++rr) { f32x4 v[8]; unpack_row(w[rr], v);
            const float r = __builtin_amdgcn_rsqf(wave_sum(sumsq8(v)) * (1.0f / D) + EPS);
            float* xr = F.out + (size_t)(m + rr) * D + 8 * F.lane;
#pragma unroll
            for (int j = 0; j < 8; ++j) *(f32x4*)(xr + 512 * (j >> 1) + 4 * (j & 1)) = v[j] * r * gg[j]; } }
}
__device__ __forceinline__ void pool_phase(Frame& F) {
    const bf16_t* P = (const bf16_t*)(F.ws + WS_P); bf16_t* BR = (bf16_t*)(F.ws + WS_BR);
    for (int it = F.bid * NTHREADS + F.tid; it < MTOK * 64; it += F.G * NTHREADS) {
        const int m = it >> 6, c = it & 63, s = seq_of_row(m), st = seq_start(s), T = seq_len(s), pos = m - st, half = 1 << (c >> 4);
        const int lo = max(pos - half, 0), hi = min(pos + half, T);
        u32x4 w[16]; const u32x4 z = (u32x4){0u, 0u, 0u, 0u};
#pragma unroll
        for (int k = 0; k < 16; ++k) { const int t = lo + k; w[k] = (t < hi) ? *(const u32x4*)(P + (size_t)(st + t) * INW + 8 * c) : z; }
        const u32x4 ws = *(const u32x4*)(P + (size_t)m * INW + 8 * c);
        float a[8];
#pragma unroll
        for (int e = 0; e < 8; ++e) a[e] = 0.f;
#pragma unroll
        for (int k = 0; k < 16; ++k) { a[0] += bflo(w[k].x); a[1] += bfhi(w[k].x); a[2] += bflo(w[k].y); a[3] += bfhi(w[k].y); a[4] += bflo(w[k].z); a[5] += bfhi(w[k].z); a[6] += bflo(w[k].w); a[7] += bfhi(w[k].w); }
        const float ic = fast_rcp((float)(hi - lo));
        u32x4 o; o.x = cvt_pk_bf16(a[0] * ic - bflo(ws.x), a[1] * ic - bfhi(ws.x)); o.y = cvt_pk_bf16(a[2] * ic - bflo(ws.y), a[3] * ic - bfhi(ws.y));
        o.z = cvt_pk_bf16(a[4] * ic - bflo(ws.z), a[5] * ic - bfhi(ws.z)); o.w = cvt_pk_bf16(a[6] * ic - bflo(ws.w), a[7] * ic - bfhi(ws.w));
        *(u32x4*)(BR + (size_t)m * D + 8 * c) = o;
    }
}
__device__ __forceinline__ void conv_fix_phase(Frame& F, int l, const float* conv_w, const float* conv_b) {
    const bf16_t* YB = (const bf16_t*)(F.ws + WS_Y); bf16_t* ACT = (bf16_t*)(F.ws + WS_ACT);
    const float* cw = conv_w + (size_t)l * 3 * NUP; const float* cb = conv_b + (size_t)l * NUP;
    for (int it = F.bid * NTHREADS + F.tid; it < 384 * 2 * 704; it += F.G * NTHREADS) {
        const int c = it % 704, be = it / 704, edge = be & 1, blk = be >> 1, row = blk * 64 + (edge ? 63 : 0);
        const int s = seq_of_row(row), pos = row - seq_start(s); const bool hasp = pos > 0, hasn = pos < seq_len(s) - 1;
        const u32x4 z = (u32x4){0u, 0u, 0u, 0u};
        const bf16_t* rp = edge ? YB + ((size_t)blk * 4 + 2) * NUP : YB + ((size_t)(blk - 1) * 4 + 3) * NUP;
        const bf16_t* rc = YB + ((size_t)blk * 4 + (edge ? 3 : 0)) * NUP;
        const bf16_t* rn = edge ? YB + ((size_t)(blk + 1) * 4 + 0) * NUP : YB + ((size_t)blk * 4 + 1) * NUP;
        const bool okp = edge ? true : hasp, okn = edge ? hasn : true;
        float o[8];
#pragma unroll
        for (int hb = 0; hb < 2; ++hb) { const int col = hb * DFF + 8 * c; float uv[8];
            const u32x4 yp = okp ? *(const u32x4*)(rp + col) : z, yc = *(const u32x4*)(rc + col), yn = okn ? *(const u32x4*)(rn + col) : z;
            const f32x4 w0a = *(const f32x4*)(cw + col), w0b = *(const f32x4*)(cw + col + 4), w1a = *(const f32x4*)(cw + NUP + col), w1b = *(const f32x4*)(cw + NUP + col + 4), w2a = *(const f32x4*)(cw + 2 * NUP + col), w2b = *(const f32x4*)(cw + 2 * NUP + col + 4);
            const f32x4 ba = *(const f32x4*)(cb + col), bb = *(const f32x4*)(cb + col + 4);
            uv[0] = bflo(yp.x) * w0a[0] + bflo(yc.x) * w1a[0] + bflo(yn.x) * w2a[0] + ba[0]; uv[1] = bfhi(yp.x) * w0a[1] + bfhi(yc.x) * w1a[1] + bfhi(yn.x) * w2a[1] + ba[1];
            uv[2] = bflo(yp.y) * w0a[2] + bflo(yc.y) * w1a[2] + bflo(yn.y) * w2a[2] + ba[2]; uv[3] = bfhi(yp.y) * w0a[3] + bfhi(yc.y) * w1a[3] + bfhi(yn.y) * w2a[3] + ba[3];
            uv[4] = bflo(yp.z) * w0b[0] + bflo(yc.z) * w1b[0] + bflo(yn.z) * w2b[0] + bb[0]; uv[5] = bfhi(yp.z) * w0b[1] + bfhi(yc.z) * w1b[1] + bfhi(yn.z) * w2b[1] + bb[1];
            uv[6] = bflo(yp.w) * w0b[2] + bflo(yc.w) * w1b[2] + bflo(yn.w) * w2b[2] + bb[2]; uv[7] = bfhi(yp.w) * w0b[3] + bfhi(yc.w) * w1b[3] + bfhi(yn.w) * w2b[3] + bb[3];
#pragma unroll
            for (int e = 0; e < 8; ++e) o[e] = hb ? o[e] * uv[e] : gelu_tanh(uv[e]); }
        u32x4 w; w.x = cvt_pk_bf16(o[0], o[1]); w.y = cvt_pk_bf16(o[2], o[3]); w.z = cvt_pk_bf16(o[4], o[5]); w.w = cvt_pk_bf16(o[6], o[7]);
        *(u32x4*)(ACT + (size_t)row * DFF + 8 * c) = w;
    }
}
constexpr int NA_SLOTS = 9;
constexpr int NAK_PITCH = 144, NAK_ROW = 64 * NAK_PITCH, NAK_BYTES = NA_SLOTS * NAK_ROW;
constexpr int NAV_PITCH = NA_SLOTS * 128 + 16, NAV_BYTES = 64 * NAV_PITCH;
constexpr int NA_RPB_OFF = NAK_BYTES + NAV_BYTES;
static_assert(NA_RPB_OFF + 465 * 4 <= LDS_MISC, "neighbourhood ring does not fit");
__device__ __forceinline__ void na_item(int I, int& s, int& h, int& r) { if (I < 2048) { s = I >> 10; h = (I >> 7) & 7; r = I & 127; } else { const int J = I - 2048; s = 2 + (J >> 9); h = (J >> 6) & 7; r = J & 63; } }
__device__ __forceinline__ void na_phase(Frame& F, int l, const float* rpb0, int part) {
    const bf16_t* P = (const bf16_t*)(F.ws + WS_P); const bf16_t* PT = (const bf16_t*)(F.ws + WS_PT); bf16_t* BR = (bf16_t*)(F.ws + WS_BR);
    const float* rpb = rpb0 + (size_t)l * 8 * 465;
    const int lane = F.lane, x = lane & 15, g = lane >> 4, qb = F.wave & 3, it = F.wave >> 2, tid = F.tid;
    LAS unsigned char* kr_ = F.lds; LAS unsigned char* vr_ = F.lds + NAK_BYTES; LAS float* rl = (LAS float*)(F.lds + NA_RPB_OFF);
    int I0, I1;
    if (F.G == 256) { const int c_ = F.bid; const int st0 = part == 0 ? (c_ < 128 ? 4 * c_ : 512 + 6 * (c_ - 128)) : 1280 + 2 * (c_ - 128), ns = part == 0 ? (c_ < 128 ? 4 : 6) : (c_ < 128 ? 0 : 2); I0 = 2 * st0; I1 = I0 + 2 * ns; }
    else { const int per = 2 * ((1536 + F.G - 1) / F.G); I0 = part == 0 ? F.bid * per : 0; I1 = part == 0 ? min(I0 + per, 3072) : 0; }
    const int w0 = qb == 0 ? 0 : (qb == 1 ? 8 : (qb == 2 ? 24 : 32));
    int cs = -1, ch = -1, hi = 0;
    const int ckey = tid >> 3, cch = tid & 7;
    u32x4 pk[2], pv[2]; int prow = -1;
    pk[0] = pk[1] = pv[0] = pv[1] = (u32x4){0u, 0u, 0u, 0u};
    for (int I = I0; I < I1; I += 2) {
        int s, h, r; na_item(I, s, h, r); const int rows = seq_len(s) >> 6, st = seq_start(s);
        const int rsA = min(max(r - 4, 0), rows - 8), rsB = min(max(r - 3, 0), rows - 8);
        const bool fresh = (s != cs) || (h != ch) || (rsA + 9 < hi) || (rsA > hi);
        const int lo_new = fresh ? rsA : hi, hi_new = rsB + 8;
        __syncthreads();
        if (fresh && (s != cs || h != ch)) { for (int i = tid; i < 465; i += NTHREADS) rl[i] = rpb[(size_t)h * 465 + i]; }
        for (int kr = lo_new; kr < hi_new; ++kr) { const int slot = kr % NA_SLOTS, tok0 = st + kr * 64; u32x4 kv, vv;
            if (!fresh && kr == prow) { kv = pk[0]; vv = pv[0]; }
            else if (!fresh && kr == prow + 1 && prow >= 0) { kv = pk[1]; vv = pv[1]; }
            else { kv = *(const u32x4*)(P + (size_t)(tok0 + ckey) * INW + 3584 + h * 64 + 8 * cch); vv = *(const u32x4*)(PT + (size_t)(1024 + h * 64 + ckey) * MTOK + tok0 + 8 * cch); }
            *(LAS u32x4*)(kr_ + slot * NAK_ROW + ckey * NAK_PITCH + 16 * cch) = kv;
            *(LAS u32x4*)(vr_ + ckey * NAV_PITCH + (slot * 64 + 8 * cch) * 2) = vv; }
        cs = s; ch = h; hi = hi_new; prow = -1;
        if (I + 2 < I1) {
            int s2, h2, r2; na_item(I + 2, s2, h2, r2); const int rows2 = seq_len(s2) >> 6, rsA2 = min(max(r2 - 4, 0), rows2 - 8), rsB2 = min(max(r2 - 3, 0), rows2 - 8);
            if (s2 == s && h2 == h && rsA2 <= hi && rsA2 + 9 >= hi && rsB2 + 8 > hi) { prow = hi;
#pragma unroll
                for (int j = 0; j < 2; ++j) { const int kr = min(hi + j, rows - 1), tok0 = st + kr * 64;
                    pk[j] = *(const u32x4*)(P + (size_t)(tok0 + ckey) * INW + 3584 + h * 64 + 8 * cch); pv[j] = *(const u32x4*)(PT + (size_t)(1024 + h * 64 + ckey) * MTOK + tok0 + 8 * cch); } } }
        const int rq = r + it, rs = it ? rsB : rsA;
        const int qtok = st + rq * 64 + 16 * qb + x;
        const bf16x8 q0 = *(const bf16x8*)(P + (size_t)qtok * INW + 3072 + h * 64 + 8 * g), q1 = *(const bf16x8*)(P + (size_t)qtok * INW + 3072 + h * 64 + 32 + 8 * g);
        __syncthreads();
        f32x4 S[16];
#pragma unroll
        for (int T = 0; T < 16; ++T) { const LAS unsigned char* kp = kr_ + ((rs + (T >> 1)) % NA_SLOTS) * NAK_ROW + (w0 + 16 * (T & 1) + x) * NAK_PITCH + 16 * g;
            f32x4 a = (f32x4){0.f, 0.f, 0.f, 0.f}; a = mfma16(*(const LAS bf16x8*)kp, q0, a); a = mfma16(*(const LAS bf16x8*)(kp + 64), q1, a); S[T] = a; }
        const int c = 16 * qb + x, cst = min(max(c - 8, 0), 48); float mx = -3.0e38f;
#pragma unroll
        for (int T = 0; T < 16; ++T) { const int dr = (rs + (T >> 1) - rq) + 7; const LAS float* rb = rl + dr * 31;
#pragma unroll
            for (int e = 0; e < 4; ++e) { const int kc = w0 + 16 * (T & 1) + 4 * g + e; const bool ok = (kc >= cst) && (kc < cst + 16); const int dc = min(max(kc - c, -15), 15) + 15;
                const float v = ok ? S[T][e] * 0.125f + rb[dc] : -1.0e30f; S[T][e] = v; mx = fmaxf(mx, v); } }
        mx = fmaxf(mx, __shfl_xor(mx, 16)); mx = fmaxf(mx, __shfl_xor(mx, 32));
        float sum = 0.f;
#pragma unroll
        for (int T = 0; T < 16; ++T)
#pragma unroll
            for (int e = 0; e < 4; ++e) { const float p = fast_exp(S[T][e] - mx); S[T][e] = p; sum += p; }
        sum += __shfl_xor(sum, 16); sum += __shfl_xor(sum, 32);
        const float inv = fast_rcp(sum);
        f32x4 O[4];
#pragma unroll
        for (int e2 = 0; e2 < 4; ++e2) O[e2] = (f32x4){0.f, 0.f, 0.f, 0.f};
#pragma unroll
        for (int ks = 0; ks < 8; ++ks) {
            u32x4 pw; pw.x = cvt_pk_bf16(S[2 * ks][0], S[2 * ks][1]); pw.y = cvt_pk_bf16(S[2 * ks][2], S[2 * ks][3]); pw.z = cvt_pk_bf16(S[2 * ks + 1][0], S[2 * ks + 1][1]); pw.w = cvt_pk_bf16(S[2 * ks + 1][2], S[2 * ks + 1][3]);
            const bf16x8 pf = __builtin_bit_cast(bf16x8, pw); const int kb = (((rs + ks) % NA_SLOTS) * 64 + w0 + 4 * g) * 2;
#pragma unroll
            for (int e2 = 0; e2 < 4; ++e2) { const LAS unsigned char* vp = vr_ + (16 * e2 + x) * NAV_PITCH + kb; const u32x2 lo = *(const LAS u32x2*)vp, hi2 = *(const LAS u32x2*)(vp + 32);
                u32x4 vw; vw.x = lo.x; vw.y = lo.y; vw.z = hi2.x; vw.w = hi2.y; O[e2] = mfma16(__builtin_bit_cast(bf16x8, vw), pf, O[e2]); } }
#pragma unroll
        for (int e2 = 0; e2 < 4; ++e2) { u32x2 w; w.x = cvt_pk_bf16(O[e2][0] * inv, O[e2][1] * inv); w.y = cvt_pk_bf16(O[e2][2] * inv, O[e2][3] * inv);
            *(u32x2*)(BR + (size_t)qtok * D + 1536 + h * 64 + 16 * e2 + 4 * g) = w; }
    }
    __syncthreads();
}
__device__ __forceinline__ float log2_sigmoid(float x) { return -__builtin_amdgcn_logf(1.0f + __builtin_amdgcn_exp2f(-x * 1.4426950408889634f)); }
constexpr int RT_PITCH = 272, RT_TILE = 128 * RT_PITCH;
__device__ __forceinline__ void decode_chunk(int u, int& s, int& h, int& n) { if (u < 512) { s = u >> 8; h = (u >> 6) & 3; n = u & 63; } else { const int v = u - 512; s = 2 + (v >> 7); h = (v >> 5) & 3; n = v & 31; } }
__device__ __forceinline__ void tile_load4(const bf16_t* src, size_t src_pitch, int tid, u32x4 (&v)[4]) {
#pragma unroll
    for (int i = 0; i < 4; ++i) { const int idx = tid + 512 * i, r = idx >> 4, ch = idx & 15; v[i] = *(const u32x4*)(src + (size_t)r * src_pitch + ch * 8); }
}
__device__ __forceinline__ void tile_store4(LAS unsigned char* dst, int tid, const u32x4 (&v)[4]) {
#pragma unroll
    for (int i = 0; i < 4; ++i) { const int idx = tid + 512 * i, r = idx >> 4, ch = idx & 15; *(LAS u32x4*)(dst + r * RT_PITCH + ch * 16) = v[i]; }
}
#define LDS_FRAG(tile, row, col) (*(const LAS bf16x8*)((tile) + (row) * RT_PITCH + (col) * 2))
__device__ __forceinline__ void ret_kv_phase(Frame& F, int l, const float* decay_f, const float* decay_b) {
    const bf16_t* P = (const bf16_t*)(F.ws + WS_P); const bf16_t* PT = (const bf16_t*)(F.ws + WS_PT); bf16_t* KV = (bf16_t*)(F.ws + WS_KV);
    const int lane = F.lane, x = lane & 15, g = lane >> 4, et = F.wave;
    LAS unsigned char* tK = F.lds; LAS unsigned char* tV = F.lds + RT_TILE;
    const int nun = (768 - F.bid + F.G - 1) / F.G;
#pragma unroll 1
    for (int ui_ = 0; ui_ < nun; ++ui_) { const int u = F.bid + ui_ * F.G;
        int s, h, n; decode_chunk(u, s, h, n); const int j0 = seq_start(s) + 128 * n;
        const float lgf = log2_sigmoid(decay_f[l * 4 + h]), lgb = log2_sigmoid(decay_b[l * 4 + h]);
        u32x4 a[4], b[4];
        tile_load4(P + (size_t)j0 * INW + 1536 + h * 128, INW, F.tid, a); tile_load4(PT + (size_t)(512 + h * 128) * MTOK + j0, MTOK, F.tid, b);
        __syncthreads();
        tile_store4(tK, F.tid, a); tile_store4(tV, F.tid, b);
        __syncthreads();
        f32x4 af[8], ab[8];
#pragma unroll
        for (int dt = 0; dt < 8; ++dt) { af[dt] = (f32x4){0.f, 0.f, 0.f, 0.f}; ab[dt] = (f32x4){0.f, 0.f, 0.f, 0.f}; }
#pragma unroll
        for (int ks = 0; ks < 4; ++ks) {
            const u32x4 vw = *(const LAS u32x4*)(tV + (16 * et + x) * RT_PITCH + (32 * ks + 8 * g) * 2);
            float v[8] = {bflo(vw.x), bfhi(vw.x), bflo(vw.y), bfhi(vw.y), bflo(vw.z), bfhi(vw.z), bflo(vw.w), bfhi(vw.w)}; float vf[8], vb[8];
#pragma unroll
            for (int e = 0; e < 8; ++e) { const int j = 32 * ks + 8 * g + e; vf[e] = v[e] * __builtin_amdgcn_exp2f(lgf * (float)(127 - j)); vb[e] = v[e] * __builtin_amdgcn_exp2f(lgb * (float)j); }
            u32x4 wf, wb; wf.x = cvt_pk_bf16(vf[0], vf[1]); wf.y = cvt_pk_bf16(vf[2], vf[3]); wf.z = cvt_pk_bf16(vf[4], vf[5]); wf.w = cvt_pk_bf16(vf[6], vf[7]);
            wb.x = cvt_pk_bf16(vb[0], vb[1]); wb.y = cvt_pk_bf16(vb[2], vb[3]); wb.z = cvt_pk_bf16(vb[4], vb[5]); wb.w = cvt_pk_bf16(vb[6], vb[7]);
            const bf16x8 bfv = __builtin_bit_cast(bf16x8, wf), bbv = __builtin_bit_cast(bf16x8, wb);
#pragma unroll
            for (int dt = 0; dt < 8; ++dt) {
                const LAS unsigned char* kp = tK + (32 * ks + 8 * g + (x >> 2)) * RT_PITCH + (16 * dt + 4 * (x & 3)) * 2;
                const bf16x4 k0 = __builtin_amdgcn_ds_read_tr16_b64_v4i16((LAS bf16x4*)kp), k1 = __builtin_amdgcn_ds_read_tr16_b64_v4i16((LAS bf16x4*)(kp + 4 * RT_PITCH));
                const bf16x8 kf = __builtin_shufflevector(k0, k1, 0, 1, 2, 3, 4, 5, 6, 7); af[dt] = mfma16(kf, bfv, af[dt]); ab[dt] = mfma16(kf, bbv, ab[dt]); }
        }
        bf16_t* o = KV + (size_t)u * 2 * 16384 + (size_t)(16 * et + x) * 128 + 4 * g;
#pragma unroll
        for (int dt = 0; dt < 8; ++dt) { u32x2 wf, wb; wf.x = cvt_pk_bf16(af[dt][0], af[dt][1]); wf.y = cvt_pk_bf16(af[dt][2], af[dt][3]); wb.x = cvt_pk_bf16(ab[dt][0], ab[dt][1]); wb.y = cvt_pk_bf16(ab[dt][2], ab[dt][3]);
            *(u32x2*)(o + 16 * dt) = wf; *(u32x2*)(o + 16384 + 16 * dt) = wb; }
    }
    __syncthreads();
}
__device__ __forceinline__ void ret_scan_phase(Frame& F, int l, const float* decay_f, const float* decay_b) {
    const bf16_t* KV = (const bf16_t*)(F.ws + WS_KV); bf16_t* RT = (bf16_t*)(F.ws + WS_RT);
    for (int it = F.bid * NTHREADS + F.tid; it < 16 * 2 * 4096; it += F.G * NTHREADS) {
        const int q = it & 4095, dir = (it >> 12) & 1, sh = it >> 13, s = sh >> 2, h = sh & 3; const int N = seq_len(s) >> 7; const int ubase = s < 2 ? s * 256 + h * 64 : 512 + (s - 2) * 128 + h * 32;
        const float lg = log2_sigmoid((dir ? decay_b : decay_f)[l * 4 + h]); const float cd = __builtin_amdgcn_exp2f(lg * 128.0f);
        f32x4 stv = (f32x4){0.f, 0.f, 0.f, 0.f};
#pragma unroll 1
        for (int k0 = 0; k0 < N; k0 += 8) { u32x2 kv[8]; size_t off[8];
#pragma unroll
            for (int j = 0; j < 8; ++j) { const int k = k0 + j, n = dir ? (N - 1 - k) : k; off[j] = ((size_t)(ubase + n) * 2 + dir) * 16384 + (size_t)q * 4; kv[j] = *(const u32x2*)(KV + off[j]); }
#pragma unroll
            for (int j = 0; j < 8; ++j) { u32x2 w; w.x = cvt_pk_bf16(stv[0], stv[1]); w.y = cvt_pk_bf16(stv[2], stv[3]); *(u32x2*)(RT + off[j]) = w; stv = stv * cd + (f32x4){bflo(kv[j].x), bfhi(kv[j].x), bflo(kv[j].y), bfhi(kv[j].y)}; } }
    }
}
__device__ __forceinline__ void ret_out_phase(Frame& F, int l, const float* decay_f, const float* decay_b) {
    const bf16_t* P = (const bf16_t*)(F.ws + WS_P); const bf16_t* PT = (const bf16_t*)(F.ws + WS_PT); const bf16_t* RT = (const bf16_t*)(F.ws + WS_RT); bf16_t* BR = (bf16_t*)(F.ws + WS_BR);
    const int lane = F.lane, x = lane & 15, g = lane >> 4, ti = F.wave;
    LAS unsigned char* tK = F.lds; LAS unsigned char* tV = F.lds + RT_TILE; LAS unsigned char* tF = F.lds + 2 * RT_TILE; LAS unsigned char* tB = F.lds + 3 * RT_TILE;
    LAS unsigned char* pl = tK + 16 * ti * RT_PITCH;
    const int nun = (768 - F.bid + F.G - 1) / F.G;
#pragma unroll 1
    for (int ui_ = 0; ui_ < nun; ++ui_) { const int u = F.bid + ui_ * F.G;
        int s, h, n; decode_chunk(u, s, h, n);
        const int j0 = seq_start(s) + 128 * n, il = 16 * ti + x, itok = j0 + il;
        const float lgf = log2_sigmoid(decay_f[l * 4 + h]), lgb = log2_sigmoid(decay_b[l * 4 + h]);
        u32x4 a[4], b[4], c[4], d[4]; bf16x8 qf[4]; u32x2 gw[8];
        tile_load4(P + (size_t)j0 * INW + 1536 + h * 128, INW, F.tid, a); tile_load4(PT + (size_t)(512 + h * 128) * MTOK + j0, MTOK, F.tid, b);
        tile_load4(RT + (size_t)u * 2 * 16384, 128, F.tid, c); tile_load4(RT + (size_t)u * 2 * 16384 + 16384, 128, F.tid, d);
#pragma unroll
        for (int ks = 0; ks < 4; ++ks) qf[ks] = *(const bf16x8*)(P + (size_t)itok * INW + 1024 + h * 128 + 32 * ks + 8 * g);
#pragma unroll
        for (int et = 0; et < 8; ++et) gw[et] = *(const u32x2*)(P + (size_t)itok * INW + 2560 + h * 128 + 16 * et + 4 * g);
        __syncthreads();
        tile_store4(tK, F.tid, a); tile_store4(tV, F.tid, b); tile_store4(tF, F.tid, c); tile_store4(tB, F.tid, d);
        __syncthreads();
        f32x4 S[8];
#pragma unroll
        for (int jt = 0; jt < 8; ++jt) { f32x4 acc = (f32x4){0.f, 0.f, 0.f, 0.f};
#pragma unroll
            for (int ks = 0; ks < 4; ++ks) acc = mfma16(LDS_FRAG(tK, 16 * jt + x, 32 * ks + 8 * g), qf[ks], acc);
#pragma unroll
            for (int e = 0; e < 4; ++e) { const int dl = il - (16 * jt + 4 * g + e); acc[e] *= dl >= 0 ? __builtin_amdgcn_exp2f(lgf * (float)dl) : __builtin_amdgcn_exp2f(lgb * (float)(-dl)); }
            S[jt] = acc; }
        f32x4 O[8];
        const float cf = __builtin_amdgcn_exp2f(lgf * (float)(il + 1)), cb = __builtin_amdgcn_exp2f(lgb * (float)(128 - il));
#pragma unroll
        for (int et = 0; et < 8; ++et) { f32x4 xf = (f32x4){0.f, 0.f, 0.f, 0.f}, xb = (f32x4){0.f, 0.f, 0.f, 0.f};
#pragma unroll
            for (int ks = 0; ks < 4; ++ks) { xf = mfma16(LDS_FRAG(tF, 16 * et + x, 32 * ks + 8 * g), qf[ks], xf); xb = mfma16(LDS_FRAG(tB, 16 * et + x, 32 * ks + 8 * g), qf[ks], xb); }
            O[et] = xf * cf + xb * cb; }
        __syncthreads();
#pragma unroll
        for (int jt = 0; jt < 8; ++jt) { u32x2 w; w.x = cvt_pk_bf16(S[jt][0], S[jt][1]); w.y = cvt_pk_bf16(S[jt][2], S[jt][3]); *(LAS u32x2*)(pl + x * RT_PITCH + (16 * jt + 4 * g) * 2) = w; }
#pragma unroll
        for (int ks = 0; ks < 4; ++ks) { const bf16x8 pf = LDS_FRAG(pl, x, 32 * ks + 8 * g);
#pragma unroll
            for (int et = 0; et < 8; ++et) O[et] = mfma16(LDS_FRAG(tV, 16 * et + x, 32 * ks + 8 * g), pf, O[et]); }
        float sm = 0.f;
#pragma unroll
        for (int et = 0; et < 8; ++et) sm += (O[et][0] + O[et][1]) + (O[et][2] + O[et][3]);
        sm += __shfl_xor(sm, 16); sm += __shfl_xor(sm, 32); const float mu = sm * (1.0f / 128.0f);
        float vq = 0.f;
#pragma unroll
        for (int et = 0; et < 8; ++et) { const f32x4 dd = O[et] - mu; vq += (dd[0] * dd[0] + dd[1] * dd[1]) + (dd[2] * dd[2] + dd[3] * dd[3]); }
        vq += __shfl_xor(vq, 16); vq += __shfl_xor(vq, 32); const float rstd = __builtin_amdgcn_rsqf(vq * (1.0f / 128.0f) + EPS);
#pragma unroll
        for (int et = 0; et < 8; ++et) { const float g0 = bflo(gw[et].x), g1 = bfhi(gw[et].x), g2 = bflo(gw[et].y), g3 = bfhi(gw[et].y);
            u32x2 w; w.x = cvt_pk_bf16((O[et][0] - mu) * rstd * g0 * sigmoidf_(g0), (O[et][1] - mu) * rstd * g1 * sigmoidf_(g1)); w.y = cvt_pk_bf16((O[et][2] - mu) * rstd * g2 * sigmoidf_(g2), (O[et][3] - mu) * rstd * g3 * sigmoidf_(g3));
            *(u32x2*)(BR + (size_t)itok * D + 1024 + h * 128 + 16 * et + 4 * g) = w; }
    }
    __syncthreads();
}

#define I_X_PROMPT (ap_->in[0])
#define I_X_SAMPLE (ap_->in[1])
#define I_C_PROMPT (ap_->in[2])
#define I_C_SAMPLE (ap_->in[3])
#define I_W_ADA (ap_->in[4])
#define I_B_ADA (ap_->in[5])
#define I_G_MIX (ap_->in[6])
#define I_W_IN (ap_->in[7])
#define I_POOL_W (ap_->in[8])
#define I_POOL_SCALE (ap_->in[9])
#define I_DECAY_F (ap_->in[10])
#define I_DECAY_B (ap_->in[11])
#define I_RPB (ap_->in[12])
#define I_W_BRANCH (ap_->in[13])
#define I_W_GATE (ap_->in[14])
#define I_B_GATE (ap_->in[15])
#define I_W_OUT (ap_->in[16])
#define I_G_FFN (ap_->in[17])
#define I_W_UP (ap_->in[18])
#define I_CONV_W (ap_->in[19])
#define I_CONV_B (ap_->in[20])
#define I_W_DOWN (ap_->in[21])
#define I_G_FINAL (ap_->in[22])
constexpr int PH_PER_LAYER = 11, PH_TOTAL = 2 + DEPTH * PH_PER_LAYER + 1;
__global__ void __launch_bounds__(NTHREADS, 2) fwd_kernel(Args args) {
    extern __shared__ __attribute__((aligned(16))) unsigned char lds_raw[];
    volatile LAS unsigned* MISC = (volatile LAS unsigned*)((LAS unsigned char*)lds_raw + LDS_MISC);
    if (threadIdx.x < 4) MISC[threadIdx.x] = 0u;
    __syncthreads();
    if (MK_N_LAUNCHES == 1) (void)xcd_barrier_post((unsigned*)(args.ws + WS_CTL) + 4096, MISC);
#if MK_N_LAUNCHES == 1
#define IN_PH() true
#define END_PH() do { XcdBarrier bar_; bar_.bar = (unsigned*)(args.ws + WS_CTL) + 4096; bar_.x = xb_xcc_id(); bar_.st = (volatile LAS unsigned*)((LAS unsigned char*)lds_raw + LDS_MISC); xcd_barrier(bar_); } while (0)
#else
    const int lo = args.ph_lo, hi = args.ph_hi; int ph = 0;
#define IN_PH() (lo <= ph && ph < hi)
#define END_PH() do { if (IN_PH() && ph + 1 < hi) { XcdBarrier bar_; bar_.bar = (unsigned*)(args.ws + WS_CTL) + 4096; bar_.x = xb_xcc_id(); bar_.st = (volatile LAS unsigned*)((LAS unsigned char*)lds_raw + LDS_MISC); xcd_barrier(bar_); } ++ph; } while (0)
#endif
#define PH_FRAME() Frame F; const __attribute__((address_space(4))) Args* ap_ = (const __attribute__((address_space(4))) Args*)__builtin_amdgcn_kernarg_segment_ptr(); asm volatile("" : "+s"(ap_)); \
        { int t_ = threadIdx.x; asm volatile("" : "+v"(t_)); unsigned char* w_ = ap_->ws; float* o_ = ap_->out; \
        unsigned l_ = 0; asm volatile("" : "+s"(l_)); F.lds = (LAS unsigned char*)lds_raw + l_; F.tid = t_; F.lane = t_ & 63; F.wave = __builtin_amdgcn_readfirstlane(t_ >> 6); int g_ = gridDim.x, b_ = blockIdx.x; asm volatile("" : "+s"(g_)); asm volatile("" : "+s"(b_)); F.G = g_; F.bid = b_; \
        F.gw = b_ * NWAVES + F.wave; F.NGW = F.G * NWAVES; F.out = o_; F.ws = w_; } \
        const float* mod = (const float*)(F.ws + WS_MOD); const int c = F.bid; (void)mod; (void)c; int l = l0; asm volatile("" : "+s"(l)); (void)l

    { const int l0 = 0;
    if (IN_PH()) { PH_FRAME(); prologue_mod_partial(F, I_C_PROMPT, I_C_SAMPLE, I_W_ADA); prologue_tables(F); convert_weights(F, 0, I_W_IN, I_W_GATE, I_W_BRANCH, I_W_OUT, I_W_UP, I_W_DOWN, I_POOL_W, I_POOL_SCALE, false); }
    END_PH();
    if (IN_PH()) { PH_FRAME(); prologue_mod_reduce(F, I_B_ADA); }
    END_PH(); }
#pragma unroll 1
    for (int l0 = 0; l0 < DEPTH; ++l0) {
#define LAYER_PTRS() const float* mod_l = mod + (size_t)l * 4 * 12288; const float* xp = (l == 0) ? I_X_PROMPT : F.out; const float* xs = (l == 0) ? I_X_SAMPLE - (size_t)16384 * D : F.out; (void)mod_l; (void)xp; (void)xs
        if (IN_PH()) { PH_FRAME(); LAYER_PTRS(); if (l > 0) convert_weights(F, l, I_W_IN, I_W_GATE, I_W_BRANCH, I_W_OUT, I_W_UP, I_W_DOWN, I_POOL_W, I_POOL_SCALE, true); __syncthreads(); if (l == 0) norm_phase<true>(F, xp, xs, I_G_MIX + (size_t)l * D, mod_l, 0, D); else norm_phase<false>(F, xp, xs, I_G_MIX + (size_t)l * D, mod_l, 0, D); }
        END_PH();
        if (IN_PH()) { PH_FRAME(); SchedG1 S{F.G, c, (const char*)(F.ws + WS_H), (const char*)(F.ws + WS_W1T)};
            EpiG1 E{(bf16_t*)(F.ws + WS_P), (bf16_t*)(F.ws + WS_PT), (bf16_t*)(F.ws + WS_GATES), I_B_GATE + (size_t)l * NGATE, (const float*)(F.ws + WS_ROPEC), (const float*)(F.ws + WS_ROPES), (const float*)(F.ws + WS_ROPECT), (const float*)(F.ws + WS_ROPEST)};
            pg8::gemm_phase<EpiG1, SchedG1>(F.lds, F.tid, 4096u, 4096u, (size_t)128 * 4096u, (size_t)128 * 4096u, S, E);
            convert_tail(F, l, I_W_IN, I_W_GATE, I_W_BRANCH, I_W_OUT, I_W_UP, I_W_DOWN, 96 * 50, CV_A, CV_QG1); }
        END_PH();
        if (IN_PH()) { { PH_FRAME(); SchedCDFT S{F.G, c, (const char*)(F.ws + WS_D2), (const char*)(F.ws + WS_P), 1}; EpiCDFT E{(bf16_t*)(F.ws + WS_YT)}; pg8::gemm_phase<EpiCDFT, SchedCDFT>(F.lds, F.tid, 256u, (unsigned)(64 * INW * 2), (size_t)128 * 256, (size_t)(INW * 2), S, E); }
            { PH_FRAME(); SchedCDFT S{F.G, c, (const char*)(F.ws + WS_D2), (const char*)(F.ws + WS_P), 0}; EpiCDFT E{(bf16_t*)(F.ws + WS_YT)}; pg8::gemm_phase<EpiCDFT, SchedCDFT>(F.lds, F.tid, 256u, (unsigned)(32 * INW * 2), (size_t)128 * 256, (size_t)(INW * 2), S, E); }
            { PH_FRAME(); pool_phase(F); }
            { PH_FRAME(); ret_kv_phase(F, l, I_DECAY_F, I_DECAY_B); }
            { PH_FRAME(); na_phase(F, l, I_RPB, 0); } }
        END_PH();
        if (IN_PH()) { { PH_FRAME(); ret_scan_phase(F, l, I_DECAY_F, I_DECAY_B); }
            { PH_FRAME(); SchedF1 S{F.G, c, (const char*)(F.ws + WS_A1), (const char*)(F.ws + WS_YT)}; EpiF1 E{(bf16_t*)(F.ws + WS_ZT), (const float*)(F.ws + WS_TWL), (const float*)(F.ws + WS_TWS)}; pg8::gemm_phase<EpiF1, SchedF1>(F.lds, F.tid, 512u, 512u, (size_t)128 * 512, (size_t)128 * 512, S, E); }
            { PH_FRAME(); na_phase(F, l, I_RPB, 1); } }
        END_PH();
        if (IN_PH()) { { PH_FRAME(); SchedF2 S{F.G, c, (const char*)(F.ws + WS_A2L), (const char*)(F.ws + WS_A2S), (const char*)(F.ws + WS_ZT)}; EpiF2 E{(bf16_t*)(F.ws + WS_BR)}; pg8::gemm_phase<EpiF2, SchedF2>(F.lds, F.tid, 256u, 256u, (size_t)128 * 256, (size_t)128 * 256, S, E); }
            { PH_FRAME(); ret_out_phase(F, l, I_DECAY_F, I_DECAY_B); } }
        END_PH();
        if (IN_PH()) {
            { PH_FRAME(); SchedMerge S{F.G, c, (const char*)(F.ws + WS_BR), (const char*)(F.ws + WS_WBRT)}; EpiMerge E{(bf16_t*)(F.ws + WS_MERGED), (const bf16_t*)(F.ws + WS_GATES), (const bf16_t*)(F.ws + WS_ZERO)}; pg8::gemm_phase<EpiMerge, SchedMerge>(F.lds, F.tid, 4096u, 1024u, (size_t)128 * 4096u, (size_t)128 * 1024u, S, E); } }
        END_PH();
        if (IN_PH()) { PH_FRAME(); LAYER_PTRS(); SchedPlain S{F.G, c, (const char*)(F.ws + WS_MERGED), (const char*)(F.ws + WS_WOUTT), 8, 32, 4096}; EpiRes E{(bf16_t*)(F.ws + WS_XB), mod_l + 2 * D};
            pg8::gemm_phase<EpiRes, SchedPlain>(F.lds, F.tid, 4096u, 4096u, (size_t)128 * 4096u, (size_t)128 * 4096u, S, E); }
        END_PH();
        if (IN_PH()) { PH_FRAME(); LAYER_PTRS(); norm_phase<false>(F, nullptr, nullptr, I_G_FFN + (size_t)l * D, mod_l, 3 * D, 4 * D); }
        END_PH();
        if (IN_PH()) { PH_FRAME(); SchedPlain S{F.G, c, (const char*)(F.ws + WS_H), (const char*)(F.ws + WS_WUPT), 44, 32, 4096}; EpiUpConv E{(bf16_t*)(F.ws + WS_ACT), (bf16_t*)(F.ws + WS_Y), I_CONV_W + (size_t)l * 3 * NUP, I_CONV_B + (size_t)l * NUP, F.lds + pg8::STAGE_BYTES};
            pg8::gemm_phase<EpiUpConv, SchedPlain>(F.lds, F.tid, 4096u, 4096u, (size_t)128 * 4096u, (size_t)128 * 4096u, S, E);
            if (l + 1 < DEPTH) convert_tail(F, l + 1, I_W_IN, I_W_GATE, I_W_BRANCH, I_W_OUT, I_W_UP, I_W_DOWN, 96 * 44, 0, CV_QUP); }
        END_PH();
        if (IN_PH()) { PH_FRAME(); conv_fix_phase(F, l, I_CONV_W, I_CONV_B); }
        END_PH();
        if (IN_PH()) { PH_FRAME(); LAYER_PTRS(); SchedPlain S{F.G, c, (const char*)(F.ws + WS_ACT), (const char*)(F.ws + WS_WDNT), 8, 88, 11264}; EpiRes E{(bf16_t*)(F.ws + WS_XB), mod_l + 5 * D};
            pg8::gemm_phase<EpiRes, SchedPlain>(F.lds, F.tid, 11264u, 11264u, (size_t)128 * 11264u, (size_t)128 * 11264u, S, E); }
        END_PH();
    }
    { const int l0 = 0; if (IN_PH()) { PH_FRAME(); final_norm_phase(F, I_G_FINAL); } }
#undef IN_PH
#undef END_PH
}

#ifdef DBG_CUT
__global__ void dbg_dump(const unsigned short* src, float* out, size_t n) { for (size_t i = (size_t)blockIdx.x * blockDim.x + threadIdx.x; i < n; i += (size_t)gridDim.x * blockDim.x) out[i] = __uint_as_float(((unsigned)src[i]) << 16); }
#endif
extern "C" void kernel_launch(void* const* d_in, const int* in_sizes, int n_in, void* d_out, int out_size, void* d_ws, size_t ws_size, hipStream_t stream) {
    static int grid = 0;
    if (grid == 0) {
        if (n_in != 23 || out_size != MTOK * D || ws_size < WS_END) { fprintf(stderr, "kernel_launch: unexpected sizes (n_in %d, out %d, ws %zu; need ws >= %zu); nothing launched\n", n_in, out_size, ws_size, (size_t)WS_END); grid = -1; return; }
        int dev = 0, cus = 0, per_cu = 0;
        if (hipGetDevice(&dev) != hipSuccess || hipDeviceGetAttribute(&cus, hipDeviceAttributeMultiprocessorCount, dev) != hipSuccess) { grid = -1; return; }
        if (hipFuncSetAttribute((const void*)fwd_kernel, hipFuncAttributeMaxDynamicSharedMemorySize, LDS_BYTES) != hipSuccess) { fprintf(stderr, "kernel_launch: hipFuncSetAttribute failed\n"); grid = -1; return; }
        if (hipOccupancyMaxActiveBlocksPerMultiprocessor(&per_cu, (const void*)fwd_kernel, NTHREADS, LDS_BYTES) != hipSuccess || per_cu < 1) { fprintf(stderr, "kernel_launch: occupancy query says %d blocks per CU\n", per_cu); }
        (void)hipGetLastError();
        grid = cus;
    }
    if (grid < 0) return;
    (void)hipMemsetAsync((char*)d_ws + WS_CTL, 0, CTL_ZERO_BYTES, stream);
#ifdef DBG_CLEAR_ALL
    (void)hipMemsetAsync((char*)d_ws + CTL_ZERO_BYTES, 0, WS_END - CTL_ZERO_BYTES, stream); (void)hipMemsetAsync(d_out, 0, (size_t)out_size * 4, stream);
#endif
    Args a{};
    for (int i = 0; i < 23; ++i) a.in[i] = (const float*)d_in[i];
    a.out = (float*)d_out; a.ws = (unsigned char*)d_ws;
#if MK_N_LAUNCHES == 1
    a.ph_lo = 0; a.ph_hi = PH_TOTAL;
    hipLaunchKernelGGL(fwd_kernel, dim3(grid), dim3(NTHREADS), LDS_BYTES, stream, a);
#else
#ifdef DBG_CUT
    for (int p = 0; p < DBG_CUT; ++p) { a.ph_lo = p; a.ph_hi = p + 1; hipLaunchKernelGGL(fwd_kernel, dim3(grid), dim3(NTHREADS), LDS_BYTES, stream, a); }
    hipLaunchKernelGGL(dbg_dump, dim3(2048), dim3(256), 0, stream, (const unsigned short*)((char*)d_ws + DBG_OFF), (float*)d_out, (size_t)DBG_N);
#else
    for (int p = 0; p < PH_TOTAL; ++p) { a.ph_lo = p; a.ph_hi = p + 1; hipLaunchKernelGGL(fwd_kernel, dim3(grid), dim3(NTHREADS), LDS_BYTES, stream, a); }
#endif
#endif
}
```
